# Optimizing an MI355X kernel written in HIP

```python
import math
import jax, jax.numpy as jnp
from jax import lax
import numpy as np

D_MODEL = 1024
BATCH = 2
SEQ = 8192
DEPTH = 1
DEC_BATCH = 128
DEC_SEQ = 4
PAST_LEN = 8192
PAGE_SIZE = 128

HEAD_DIM = 64
ATTN_WIDTH = D_MODEL // 2
N_Q_HEADS = ATTN_WIDTH // HEAD_DIM
N_KV_HEADS = N_Q_HEADS // 4
Q_PER_KV = N_Q_HEADS // N_KV_HEADS
KV_WIDTH = N_KV_HEADS * HEAD_DIM
WINDOW = 128
BLOCK = 128
N_BUCKETS = 32
MAX_DISTANCE = 128
SSM_WIDTH = D_MODEL - ATTN_WIDTH
SSM_GROUP = 16
N_SSM_GROUPS = SSM_WIDTH // SSM_GROUP
SSM_STATE = 64
D_FF = 4 * D_MODEL
D_IN_PROJ = ATTN_WIDTH + 2 * KV_WIDTH + SSM_WIDTH
DT_MIN = 0.001
DT_MAX = 0.1
EPS = 1e-6
NEG = -1e30

kernel_name = "hymba_swa_sink_s5_decode_step"


def rmsnorm(x, g):
    xf = x.astype(jnp.float32)
    y = xf * lax.rsqrt(jnp.mean(xf * xf, axis=-1, keepdims=True) + EPS)
    return (y * g.astype(jnp.float32)).astype(x.dtype)


def rel_bucket(dist):
    n = jnp.maximum(dist, 0)
    max_exact = N_BUCKETS // 2
    nf = jnp.maximum(n, max_exact).astype(jnp.float32)
    large = max_exact + (jnp.log(nf / max_exact) / math.log(MAX_DISTANCE / max_exact)
                         * (N_BUCKETS - max_exact)).astype(jnp.int32)
    large = jnp.minimum(large, N_BUCKETS - 1)
    return jnp.where(n < max_exact, n, large)


def band_attention(q, k, v, dist, valid, sinks, rel_table):
    bias = rel_table[rel_bucket(dist)]
    bias = jnp.transpose(bias, (2, 0, 1)).reshape(N_KV_HEADS, Q_PER_KV, *dist.shape).astype(jnp.float32)
    s = jnp.einsum('bnqgrd,bnkgd->bngrqk', q, k).astype(jnp.float32) * (HEAD_DIM ** -0.5) + bias
    s = jnp.where(valid[:, None, None], s, NEG)
    sink = sinks.astype(jnp.float32).reshape(N_KV_HEADS, Q_PER_KV, 1)
    m = jnp.maximum(jnp.max(s, axis=-1), sink)
    p = jnp.exp(s - m[..., None])
    denom = jnp.sum(p, axis=-1) + jnp.exp(sink - m)
    p = (p / denom[..., None]).astype(v.dtype)
    return jnp.einsum('bngrqk,bnkgd->bnqgrd', p, v)


def attn_prompt(q, k, v, sinks, rel_table):
    b, L = q.shape[:2]
    nb = L // BLOCK
    qb = q.reshape(b, nb, BLOCK, N_KV_HEADS, Q_PER_KV, HEAD_DIM)
    kb = k.reshape(b, nb, BLOCK, N_KV_HEADS, HEAD_DIM)
    vb = v.reshape(b, nb, BLOCK, N_KV_HEADS, HEAD_DIM)

    def band(t):
        prev = jnp.concatenate([jnp.zeros_like(t[:, :1]), t[:, :-1]], axis=1)
        return jnp.concatenate([prev, t], axis=2)

    i = jnp.arange(BLOCK)[:, None]
    j = jnp.arange(2 * BLOCK)[None, :]
    dist = i + BLOCK - j
    in_band = (dist >= 0) & (dist < WINDOW)
    first = (jnp.arange(nb) == 0)[:, None, None]
    valid = in_band[None] & ~(first & (j < BLOCK)[None])
    o = band_attention(qb, band(kb), band(vb), dist, valid, sinks, rel_table)
    return o.reshape(b, L, ATTN_WIDTH)


def attn_sample(q, k_new, v_new, k_cache, v_cache, sinks, rel_table):
    b, T = q.shape[:2]
    keys = jnp.concatenate([k_cache, k_new], axis=1)
    vals = jnp.concatenate([v_cache, v_new], axis=1)
    i = jnp.arange(T)[:, None]
    key_pos = jnp.arange(WINDOW + T)[None, :] - WINDOW
    dist = i - key_pos
    valid = ((dist >= 0) & (dist < WINDOW))[None]
    o = band_attention(q[:, None], keys[:, None], vals[:, None], dist, valid, sinks, rel_table)
    return o.reshape(b, T, ATTN_WIDTH), keys[:, T:], vals[:, T:]


def s5_mixer(u, h0, a_re, a_im, log_step, b_re, b_im, c_re, c_im, d, w_glu, b_glu):
    f32 = jnp.float32
    b, L = u.shape[:2]
    uf = u.astype(f32).reshape(b, L, N_SSM_GROUPS, SSM_GROUP)
    lam = lax.complex(a_re.astype(f32), a_im.astype(f32))
    step = jnp.exp(log_step.astype(f32))[:, None]
    lam_bar = jnp.exp(lam * step)
    b_bar = ((lam_bar - 1.0) / lam)[..., None] * lax.complex(b_re.astype(f32), b_im.astype(f32))
    bu = jnp.einsum('blgc,gpc->blgp', uf.astype(jnp.complex64), b_bar)
    if h0 is not None:
        bu = bu.at[:, 0].add(lam_bar * h0)
    a = jnp.broadcast_to(lam_bar, bu.shape)

    def combine(e1, e2):
        a1, b1 = e1
        a2, b2 = e2
        return a1 * a2, a2 * b1 + b2

    _, h = lax.associative_scan(combine, (a, bu), axis=1)
    c = lax.complex(c_re.astype(f32), c_im.astype(f32))
    y = jnp.real(jnp.einsum('blgp,gcp->blgc', h, c)) + d.astype(f32) * uf
    y = y.reshape(b, L, SSM_WIDTH)
    g = jax.nn.gelu(y)
    out = g * jax.nn.sigmoid(g @ w_glu.astype(f32) + b_glu.astype(f32))
    return out.astype(u.dtype), h[:, -1]


def layer_forward(x, lw, rel_table, kv_cache, ssm_h0):
    b, L, _ = x.shape
    h = rmsnorm(x, lw['norm_mix'])
    proj = h @ lw['w_in']
    q, k, v, u = jnp.split(proj, [ATTN_WIDTH, ATTN_WIDTH + KV_WIDTH, ATTN_WIDTH + 2 * KV_WIDTH], axis=-1)
    q = q.reshape(b, L, N_KV_HEADS, Q_PER_KV, HEAD_DIM)
    k = k.reshape(b, L, N_KV_HEADS, HEAD_DIM)
    v = v.reshape(b, L, N_KV_HEADS, HEAD_DIM)
    if kv_cache is None:
        o_attn = attn_prompt(q, k, v, lw['sinks'], rel_table)
        new_k, new_v = k[:, L - WINDOW:], v[:, L - WINDOW:]
    else:
        o_attn, new_k, new_v = attn_sample(q, k, v, kv_cache[0], kv_cache[1], lw['sinks'], rel_table)
    o_ssm, h_last = s5_mixer(u, ssm_h0, lw['a_re'], lw['a_im'], lw['log_step'], lw['b_re'], lw['b_im'],
                             lw['c_re'], lw['c_im'], lw['d'], lw['w_glu'], lw['b_glu'])
    merged = jnp.concatenate([rmsnorm(o_attn, lw['norm_attn_out']), rmsnorm(o_ssm, lw['norm_ssm_out'])], axis=-1)
    x = x + merged @ lw['w_out']
    hm = rmsnorm(x, lw['norm_mlp'])
    x = x + jnp.square(jax.nn.relu(hm @ lw['w_up'])) @ lw['w_down']
    return x, new_k, new_v, jnp.real(h_last), jnp.imag(h_last)


def setup_inputs(seed: int = 0) -> dict:
    key = jax.random.key(seed)
    ks = jax.random.split(key, 32)
    f32 = jnp.float32
    nrm = lambda k, shape, s: jax.random.normal(k, shape, f32) * s
    gain = lambda k, shape: 1.0 + 0.02 * jax.random.normal(k, shape, f32)
    a_im_base = math.pi * jnp.arange(SSM_STATE, dtype=f32)
    return {
        'x_prompt': nrm(ks[0], (BATCH, SEQ, D_MODEL), 1.0),
        'x_sample': nrm(ks[1], (DEC_BATCH, DEC_SEQ, D_MODEL), 1.0),
        'cache_k': nrm(ks[2], (DEPTH, DEC_BATCH, WINDOW, N_KV_HEADS, HEAD_DIM), 1.0),
        'cache_v': nrm(ks[3], (DEPTH, DEC_BATCH, WINDOW, N_KV_HEADS, HEAD_DIM), 1.0),
        'state_ssm_re': nrm(ks[4], (DEPTH, DEC_BATCH, N_SSM_GROUPS, SSM_STATE), 0.5),
        'state_ssm_im': nrm(ks[5], (DEPTH, DEC_BATCH, N_SSM_GROUPS, SSM_STATE), 0.5),
        'rel_bias': nrm(ks[6], (N_BUCKETS, N_Q_HEADS), 0.2),
        'norm_mix': gain(ks[7], (DEPTH, D_MODEL)),
        'w_in': nrm(ks[8], (DEPTH, D_MODEL, D_IN_PROJ), D_MODEL ** -0.5),
        'attn_sinks': nrm(ks[9], (DEPTH, N_Q_HEADS), 0.5),
        'ssm_a_re': -0.5 + nrm(ks[10], (DEPTH, N_SSM_GROUPS, SSM_STATE), 0.01),
        'ssm_a_im': a_im_base + nrm(ks[11], (DEPTH, N_SSM_GROUPS, SSM_STATE), 0.01),
        'ssm_log_step': jax.random.uniform(ks[12], (DEPTH, N_SSM_GROUPS), f32,
                                           minval=math.log(DT_MIN), maxval=math.log(DT_MAX)),
        'ssm_b_re': nrm(ks[13], (DEPTH, N_SSM_GROUPS, SSM_STATE, SSM_GROUP), (2 * SSM_GROUP) ** -0.5),
        'ssm_b_im': nrm(ks[14], (DEPTH, N_SSM_GROUPS, SSM_STATE, SSM_GROUP), (2 * SSM_GROUP) ** -0.5),
        'ssm_c_re': nrm(ks[15], (DEPTH, N_SSM_GROUPS, SSM_GROUP, SSM_STATE), SSM_STATE ** -0.5),
        'ssm_c_im': nrm(ks[16], (DEPTH, N_SSM_GROUPS, SSM_GROUP, SSM_STATE), SSM_STATE ** -0.5),
        'ssm_d': nrm(ks[17], (DEPTH, N_SSM_GROUPS, SSM_GROUP), 1.0),
        'w_glu': nrm(ks[18], (DEPTH, SSM_WIDTH, SSM_WIDTH), SSM_WIDTH ** -0.5),
        'b_glu': nrm(ks[19], (DEPTH, SSM_WIDTH), 0.02),
        'norm_attn_out': gain(ks[20], (DEPTH, ATTN_WIDTH)),
        'norm_ssm_out': gain(ks[21], (DEPTH, SSM_WIDTH)),
        'w_out': nrm(ks[22], (DEPTH, D_MODEL, D_MODEL), D_MODEL ** -0.5),
        'norm_mlp': gain(ks[23], (DEPTH, D_MODEL)),
        'w_up': nrm(ks[24], (DEPTH, D_MODEL, D_FF), D_MODEL ** -0.5),
        'w_down': nrm(ks[25], (DEPTH, D_FF, D_MODEL), D_FF ** -0.5),
        'norm_final': gain(ks[26], (D_MODEL,)),
    }


def reference(x_prompt, x_sample, cache_k, cache_v, state_ssm_re, state_ssm_im, rel_bias,
              norm_mix, w_in, attn_sinks, ssm_a_re, ssm_a_im, ssm_log_step, ssm_b_re, ssm_b_im,
              ssm_c_re, ssm_c_im, ssm_d, w_glu, b_glu, norm_attn_out, norm_ssm_out, w_out,
              norm_mlp, w_up, w_down, norm_final):
    xp, xs = x_prompt, x_sample
    kp, vp, rep, imp = [], [], [], []
    ksm, vsm, res, ims = [], [], [], []
    for l in range(DEPTH):
        lw = {'norm_mix': norm_mix[l], 'w_in': w_in[l], 'sinks': attn_sinks[l],
              'a_re': ssm_a_re[l], 'a_im': ssm_a_im[l], 'log_step': ssm_log_step[l],
              'b_re': ssm_b_re[l], 'b_im': ssm_b_im[l], 'c_re': ssm_c_re[l], 'c_im': ssm_c_im[l],
              'd': ssm_d[l], 'w_glu': w_glu[l], 'b_glu': b_glu[l],
              'norm_attn_out': norm_attn_out[l], 'norm_ssm_out': norm_ssm_out[l], 'w_out': w_out[l],
              'norm_mlp': norm_mlp[l], 'w_up': w_up[l], 'w_down': w_down[l]}
        xp, k1, v1, r1, i1 = layer_forward(xp, lw, rel_bias, None, None)
        h0 = lax.complex(state_ssm_re[l].astype(jnp.float32), state_ssm_im[l].astype(jnp.float32))
        xs, k2, v2, r2, i2 = layer_forward(xs, lw, rel_bias, (cache_k[l], cache_v[l]), h0)
        kp.append(k1); vp.append(v1); rep.append(r1); imp.append(i1)
        ksm.append(k2); vsm.append(v2); res.append(r2); ims.append(i2)
    y_prompt = rmsnorm(xp, norm_final)
    y_sample = rmsnorm(xs, norm_final)
    return (y_prompt, y_sample,
            jnp.stack(kp), jnp.stack(vp), jnp.stack(rep), jnp.stack(imp),
            jnp.stack(ksm), jnp.stack(vsm), jnp.stack(res), jnp.stack(ims))
```

```cpp
#include <hip/hip_runtime.h>
#include <cstdio>
#include <cstdint>
namespace pg8 {
#define PG8_LAS __attribute__((address_space(3)))
typedef unsigned short bf16_t;
typedef short bf16x8 __attribute__((ext_vector_type(8)));
typedef float f32x4 __attribute__((ext_vector_type(4)));
typedef unsigned u32x4 __attribute__((ext_vector_type(4)));
constexpr int BM = 256, BK = 64, HALF = 128, HTB = HALF * BK * 2  , STAGE_BYTES = 8 * HTB, NXCD = 8, WGM = 8;

__host__ __device__ __forceinline__ int lds_byte(int r, int c) { const int st = (r >> 4) * 2 + (c >> 5), rr = r & 15, cc = c & 31, ob = rr * 64 + cc * 2; return st * 1024 + (ob ^ (((ob >> 9) & 1) << 5)); }
__host__ __device__ __forceinline__ void stage_rc(int b, int& R, int& C) { const int st = b / 1024, sb = b % 1024, swz = sb ^ (((sb >> 9) & 1) << 5); R = (st >> 1) * 16 + swz / 64; C = (st & 1) * 32 + (swz % 64) / 2; }
__host__ __device__ __forceinline__ int perm32(int rho) { const int n = rho >> 4, i = rho & 15; return 8 * (i >> 2) + 4 * n + (i & 3); }

struct Unit { int pm, pn; };
struct Gemm { const bf16_t* A; const bf16_t* Bt; int M, N, K; };

struct StaticOrder {
    int nM, nN, nwg, G, c;
    __host__ __device__ void init(int M, int N, int G_, int c_) { nM = M / BM; nN = N / BM; nwg = nM * nN; G = G_; c = c_; }
    __host__ __device__ bool next(int i, Unit& u) const {
        const long L = (long)i * G + c; if (L >= nwg) return false;
        int wgid = (int)L; { const int q = nwg / NXCD, r = nwg % NXCD, xcd = wgid % NXCD, off = wgid / NXCD; wgid = (xcd < r ? xcd * (q + 1) : r * (q + 1) + (xcd - r) * q) + off; }
        const int nig = WGM * nN, gid = wgid / nig, fm = gid * WGM, gsz = (nM - fm) < WGM ? (nM - fm) : WGM;
        u.pm = fm + ((wgid % nig) % gsz); u.pn = (wgid % nig) / gsz; return true;
    }
    __device__ __forceinline__ void a_ready(const Unit&) const {}
    __device__ __forceinline__ void done(const Unit&) const {}
};


__device__ __forceinline__ unsigned cvt_pk_bf16(float lo, float hi) { unsigned r; asm volatile("v_cvt_pk_bf16_f32 %0, %1, %2" : "=v"(r) : "v"(lo), "v"(hi)); return r; }

struct EpiInProj {
    static constexpr bool PERM = true, AFTER_DRAIN = false;
    bf16_t* O; float* out; int ldc; int pad;
    __device__ __forceinline__ void operator()(const f32x4 (&acc)[2][2][4][2], const Unit& u, int wr, int wc, int fr, int fq) const {
        const int row0 = u.pm * BM + wr * 64 + fr; const int col0 = u.pn * BM + wc * 32 + 8 * fq;
#pragma unroll
        for (int ai = 0; ai < 2; ++ai)
#pragma unroll
            for (int m = 0; m < 4; ++m) { const int row = row0 + ai * HALF + m * 16; bf16_t* rowp = O + (size_t)row * ldc + col0;
#pragma unroll
                for (int bj = 0; bj < 2; ++bj) { const f32x4 v0 = acc[ai][bj][m][0], v1 = acc[ai][bj][m][1];
                    u32x4 w; w.x = cvt_pk_bf16(v0[0], v0[1]); w.y = cvt_pk_bf16(v0[2], v0[3]); w.z = cvt_pk_bf16(v1[0], v1[1]); w.w = cvt_pk_bf16(v1[2], v1[3]);
                    *(u32x4*)(rowp + bj * HALF) = w; }
                if (u.pn == 2) {
                    long dst = -1;
                    if (row < 16384) { const int t = row & 8191, b = row >> 13; if (t >= 8192 - 128) dst = (long)(b * 128 + (t - (8192 - 128))) * 128; }
                    else { const int si = row - 16384; dst = (long)((si >> 2) * 128 + 124 + (si & 3)) * 128; }
                    if (dst >= 0) { const int kc = wc * 32 + 8 * fq;
                        float* kd = out + (row < 16384 ? 17301504L : 17375232L) + dst + kc;
                        float* vd = out + (row < 16384 ? 17334272L : 19472384L) + dst + kc;
                        *(f32x4*)(kd) = acc[ai][0][m][0]; *(f32x4*)(kd + 4) = acc[ai][0][m][1];
                        *(f32x4*)(vd) = acc[ai][1][m][0]; *(f32x4*)(vd + 4) = acc[ai][1][m][1]; }
                }
            }
    }
};
struct EpiF32Res {
    static constexpr bool PERM = false, AFTER_DRAIN = false;
    const float* b0; const float* b1; float* O; int ldc; int pad;
    __device__ __forceinline__ void operator()(const f32x4 (&acc)[2][2][4][2], const Unit& u, int wr, int wc, int fr, int fq) const {
        const int row0 = u.pm * BM + wr * 64 + fr; const int col0 = u.pn * BM + wc * 32 + 4 * fq;
#pragma unroll
        for (int ai = 0; ai < 2; ++ai)
#pragma unroll
            for (int m = 0; m < 4; ++m) { const int row = row0 + ai * HALF + m * 16;
                const float* bp = (row < 16384 ? b0 + (size_t)row * ldc : b1 + (size_t)(row - 16384) * ldc) + col0; float* op = O + (size_t)row * ldc + col0;
#pragma unroll
                for (int bj = 0; bj < 2; ++bj)
#pragma unroll
                    for (int n = 0; n < 2; ++n) { const f32x4 bs = *(const f32x4*)(bp + bj * HALF + n * 16); *(f32x4*)(op + bj * HALF + n * 16) = bs + acc[ai][bj][m][n]; }
            }
    }
};
struct EpiRelu2 {
    static constexpr bool PERM = true, AFTER_DRAIN = false;
    bf16_t* O; int ldc; int pad;
    __device__ __forceinline__ void operator()(const f32x4 (&acc)[2][2][4][2], const Unit& u, int wr, int wc, int fr, int fq) const {
        const int row0 = u.pm * BM + wr * 64 + fr; const int col0 = u.pn * BM + wc * 32 + 8 * fq;
#pragma unroll
        for (int ai = 0; ai < 2; ++ai)
#pragma unroll
            for (int m = 0; m < 4; ++m) { bf16_t* rowp = O + (size_t)(row0 + ai * HALF + m * 16) * ldc + col0;
#pragma unroll
                for (int bj = 0; bj < 2; ++bj) { f32x4 v0 = acc[ai][bj][m][0], v1 = acc[ai][bj][m][1];
#pragma unroll
                    for (int j = 0; j < 4; ++j) { const float a = fmaxf(v0[j], 0.f), b = fmaxf(v1[j], 0.f); v0[j] = a * a; v1[j] = b * b; }
                    u32x4 w; w.x = cvt_pk_bf16(v0[0], v0[1]); w.y = cvt_pk_bf16(v0[2], v0[3]); w.z = cvt_pk_bf16(v1[0], v1[1]); w.w = cvt_pk_bf16(v1[2], v1[3]);
                    *(u32x4*)(rowp + bj * HALF) = w; } }
    }
};
__device__ __forceinline__ float bf2f(bf16_t b) { return __uint_as_float((unsigned)b << 16); }
struct EpiGlu {
    static constexpr bool PERM = false, AFTER_DRAIN = false;
    const bf16_t* G; const float* bias; float* O; int ldc; int pad;
    __device__ __forceinline__ void operator()(const f32x4 (&acc)[2][2][4][2], const Unit& u, int wr, int wc, int fr, int fq) const {
        const int row0 = u.pm * BM + wr * 64 + fr; const int col0 = u.pn * BM + wc * 32 + 4 * fq;
#pragma unroll
        for (int ai = 0; ai < 2; ++ai)
#pragma unroll
            for (int m = 0; m < 4; ++m) { const size_t ro = (size_t)(row0 + ai * HALF + m * 16) * ldc + col0;
#pragma unroll
                for (int bj = 0; bj < 2; ++bj)
#pragma unroll
                    for (int n = 0; n < 2; ++n) { const int co = bj * HALF + n * 16; const f32x4 bv = *(const f32x4*)(bias + col0 + co);
                        const unsigned long long gw = *(const unsigned long long*)(G + ro + co); f32x4 o;
#pragma unroll
                        for (int j = 0; j < 4; ++j) { const float g = bf2f((bf16_t)(gw >> (16 * j))); const float z = acc[ai][bj][m][n][j] + bv[j]; o[j] = g / (1.f + __expf(-z)); }
                        *(f32x4*)(O + ro + co) = o; }
            }
    }
};
template <class Epi, class Sched, bool ALIGN_EPI = false, bool SP2 = false>
__device__ __forceinline__ void gemm_phase(PG8_LAS unsigned char* lds, const Gemm g, const Sched& S, const Epi& E) {
    const int tid = threadIdx.x, wid = __builtin_amdgcn_readfirstlane(tid >> 6), lane = tid & 63, wr = wid >> 2, wc = wid & 3, fr = lane & 15, fq = lane >> 4;
    const int K = g.K, nt = K / BK;
    unsigned voffA[2], voffB[2];
#pragma unroll
    for (int i = 0; i < 2; ++i) { int R, C; stage_rc(tid * 16 + i * 8192, R, C); const int Rb = Epi::PERM ? ((R & ~31) + perm32(R & 31)) : R;
        voffA[i] = (unsigned)(R * K + C) * 2u; voffB[i] = (unsigned)(Rb * K + C) * 2u; }
    const size_t kstep = (size_t)(BK * 2);
    const size_t hstep = (size_t)HALF * K * 2;
    const size_t tstep = 2 * hstep;
    const unsigned ldsw = (unsigned)wid * 1024u;
    const int aoff = lds_byte(wr * 64 + fr, fq * 8), boff = lds_byte(wc * 32 + fr, fq * 8);
#define PG8_SA(b, h) (((b) * 2 + (h)) * HTB)
#define PG8_SB(b, h) ((4 + (b) * 2 + (h)) * HTB)
#define PG8_STAGE(bufoff, gbase, voff) do { _Pragma("unroll") for (int _i = 0; _i < 2; ++_i) \
        __builtin_amdgcn_global_load_lds((const unsigned*)((const char*)(gbase) + (voff)[_i]), (PG8_LAS unsigned*)(lds + (bufoff) + ldsw + _i * 8192), 16, 0, 0); } while (0)
#define PG8_LDA(dst, b, h) do { _Pragma("unroll") for (int m = 0; m < 4; ++m) _Pragma("unroll") for (int k = 0; k < 2; ++k) dst[m][k] = *(const PG8_LAS bf16x8*)(lds + PG8_SA(b, h) + aoff + m * 2048 + k * 1024); } while (0)
#define PG8_LDB(dst, b, h) do { _Pragma("unroll") for (int n = 0; n < 2; ++n) _Pragma("unroll") for (int k = 0; k < 2; ++k) dst[n][k] = *(const PG8_LAS bf16x8*)(lds + PG8_SB(b, h) + boff + n * 2048 + k * 1024); } while (0)
#define PG8_MMA(ai, bj, At, Bt) do { __builtin_amdgcn_s_setprio(1); _Pragma("unroll") for (int m = 0; m < 4; ++m) _Pragma("unroll") for (int n = 0; n < 2; ++n) _Pragma("unroll") for (int k = 0; k < 2; ++k) \
        acc[ai][bj][m][n] = __builtin_amdgcn_mfma_f32_16x16x32_bf16(Bt[n][k], At[m][k], acc[ai][bj][m][n], 0, 0, 0); __builtin_amdgcn_s_setprio(0); } while (0)
#define PG8_WAIT_V(n) asm volatile("s_waitcnt vmcnt(" #n ")" ::: "memory")
#define PG8_WAIT_L(n) asm volatile("s_waitcnt lgkmcnt(" #n ")" ::: "memory")
#define PG8_BAR __builtin_amdgcn_s_barrier()
#define PG8_SCHED __builtin_amdgcn_sched_barrier(0)
    Unit cur, nxt; int ui = 0;
    if (!S.next(0, cur)) return;
    f32x4 acc[2][2][4][2];
#pragma unroll
    for (int a = 0; a < 2; ++a)
#pragma unroll
        for (int b = 0; b < 2; ++b)
#pragma unroll
            for (int m = 0; m < 4; ++m)
#pragma unroll
                for (int n = 0; n < 2; ++n) acc[a][b][m][n] = (f32x4){0.f, 0.f, 0.f, 0.f};
    bf16x8 At[4][2], B0[2][2], B1[2][2];
    const char* cA = (const char*)g.A + (size_t)cur.pm * tstep; const char* cB = (const char*)g.Bt + (size_t)cur.pn * tstep;
    S.a_ready(cur);
    if constexpr (SP2) {
        PG8_STAGE(PG8_SB(0, 0), cB, voffB); PG8_STAGE(PG8_SB(0, 1), cB + hstep, voffB); PG8_STAGE(PG8_SA(0, 0), cA, voffA); PG8_STAGE(PG8_SA(0, 1), cA + hstep, voffA);
        if (wr == 1) PG8_BAR;
        PG8_WAIT_V(2); PG8_BAR;
        PG8_STAGE(PG8_SB(1, 0), cB + kstep, voffB); PG8_STAGE(PG8_SA(1, 0), cA + kstep, voffA); PG8_STAGE(PG8_SB(1, 1), cB + hstep + kstep, voffB);
        PG8_WAIT_V(6); PG8_BAR;
    } else {
        PG8_STAGE(PG8_SB(0, 0), cB, voffB); PG8_STAGE(PG8_SA(0, 0), cA, voffA); PG8_STAGE(PG8_SB(0, 1), cB + hstep, voffB); PG8_STAGE(PG8_SA(0, 1), cA + hstep, voffA);
        if (wr == 1) PG8_BAR;
        PG8_WAIT_V(4); PG8_BAR;
        PG8_STAGE(PG8_SB(1, 0), cB + kstep, voffB); PG8_STAGE(PG8_SA(1, 0), cA + kstep, voffA); PG8_STAGE(PG8_SB(1, 1), cB + hstep + kstep, voffB);
        PG8_WAIT_V(6); PG8_BAR;
    }
    for (;;) {
        const bool has_next = S.next(ui + 1, nxt);
        const char* nA = has_next ? (const char*)g.A + (size_t)nxt.pm * tstep : cA; const char* nB = has_next ? (const char*)g.Bt + (size_t)nxt.pn * tstep : cB;
        for (int t = 0; t < nt; t += 2) {
            const bool last = (t == nt - 2);
            const char* a1 = cA + (size_t)(t + 1) * kstep;
            const char* a2 = last ? nA : cA + (size_t)(t + 2) * kstep; const char* b2 = last ? nB : cB + (size_t)(t + 2) * kstep;
            const char* a3 = a2 + kstep; const char* b3 = b2 + kstep;
            if (last && has_next) S.a_ready(nxt);
            if constexpr (SP2) {
            PG8_LDB(B0, 0, 0); PG8_LDB(B1, 0, 1); PG8_SCHED; PG8_LDA(At, 0, 0); PG8_STAGE(PG8_SA(1, 1), a1 + hstep, voffA);
            PG8_WAIT_V(8); PG8_WAIT_L(0); PG8_BAR; PG8_MMA(0, 0, At, B0); PG8_MMA(0, 1, At, B1); PG8_BAR; PG8_SCHED;
            PG8_LDA(At, 0, 1); PG8_STAGE(PG8_SB(0, 0), b2, voffB); PG8_STAGE(PG8_SB(0, 1), b2 + hstep, voffB); PG8_STAGE(PG8_SA(0, 0), a2, voffA);
            PG8_WAIT_V(8); PG8_WAIT_L(0); PG8_BAR; PG8_MMA(1, 0, At, B0); PG8_MMA(1, 1, At, B1); PG8_BAR; PG8_SCHED;
            PG8_LDB(B0, 1, 0); PG8_LDB(B1, 1, 1); PG8_SCHED; PG8_LDA(At, 1, 0); PG8_STAGE(PG8_SA(0, 1), a2 + hstep, voffA);
            PG8_WAIT_V(8); PG8_WAIT_L(0); PG8_BAR; PG8_MMA(0, 0, At, B0); PG8_MMA(0, 1, At, B1); PG8_BAR; PG8_SCHED;
            PG8_LDA(At, 1, 1); PG8_STAGE(PG8_SB(1, 0), b3, voffB); PG8_STAGE(PG8_SB(1, 1), b3 + hstep, voffB); PG8_STAGE(PG8_SA(1, 0), a3, voffA);
            PG8_WAIT_V(8); PG8_WAIT_L(0); PG8_BAR; PG8_MMA(1, 0, At, B0); PG8_MMA(1, 1, At, B1); PG8_BAR; PG8_SCHED;
            } else {
            PG8_LDB(B0, 0, 0); PG8_SCHED; PG8_LDA(At, 0, 0); PG8_STAGE(PG8_SA(1, 1), a1 + hstep, voffA);
            PG8_WAIT_L(8); PG8_BAR; PG8_WAIT_L(0); PG8_MMA(0, 0, At, B0); PG8_BAR; PG8_SCHED;
            PG8_LDB(B1, 0, 1); PG8_STAGE(PG8_SB(0, 0), b2, voffB);
            PG8_BAR; PG8_WAIT_L(0); PG8_MMA(0, 1, At, B1); PG8_BAR;
            PG8_LDA(At, 0, 1); PG8_STAGE(PG8_SA(0, 0), a2, voffA);
            PG8_BAR; PG8_WAIT_L(0); PG8_MMA(1, 0, At, B0); PG8_BAR; PG8_SCHED;
            PG8_STAGE(PG8_SB(0, 1), b2 + hstep, voffB);
            PG8_WAIT_V(6); PG8_BAR; PG8_MMA(1, 1, At, B1); PG8_BAR;
            PG8_LDB(B0, 1, 0); PG8_SCHED; PG8_LDA(At, 1, 0); PG8_STAGE(PG8_SA(0, 1), a2 + hstep, voffA);
            PG8_WAIT_L(8); PG8_BAR; PG8_WAIT_L(0); PG8_MMA(0, 0, At, B0); PG8_BAR; PG8_SCHED;
            PG8_LDB(B1, 1, 1); PG8_STAGE(PG8_SB(1, 0), b3, voffB);
            PG8_BAR; PG8_WAIT_L(0); PG8_MMA(0, 1, At, B1); PG8_BAR;
            PG8_LDA(At, 1, 1); PG8_STAGE(PG8_SA(1, 0), a3, voffA);
            PG8_BAR; PG8_WAIT_L(0); PG8_MMA(1, 0, At, B0); PG8_BAR; PG8_SCHED;
            PG8_STAGE(PG8_SB(1, 1), b3 + hstep, voffB);
            PG8_WAIT_V(6); PG8_BAR; PG8_MMA(1, 1, At, B1); PG8_BAR;
            }
        }
        if constexpr (ALIGN_EPI) { if (wr == 0) PG8_BAR; }
        if constexpr (!Epi::AFTER_DRAIN) { E(acc, cur, wr, wc, fr, fq); S.done(cur); }
        if (!has_next) break;
#pragma unroll
        for (int a = 0; a < 2; ++a)
#pragma unroll
            for (int b = 0; b < 2; ++b)
#pragma unroll
                for (int m = 0; m < 4; ++m)
#pragma unroll
                    for (int n = 0; n < 2; ++n) acc[a][b][m][n] = (f32x4){0.f, 0.f, 0.f, 0.f};
        cur = nxt; cA = nA; cB = nB; ++ui;
        if constexpr (ALIGN_EPI) { if (wr == 1) PG8_BAR; }
    }
    PG8_WAIT_V(0);
    if constexpr (!ALIGN_EPI) { if (wr == 0) PG8_BAR; }
    PG8_BAR;
    if constexpr (Epi::AFTER_DRAIN) { E.fused(acc, cur, wr, wc, fr, fq, lds, wid, lane); S.done(cur); }
#undef PG8_SA
#undef PG8_SB
#undef PG8_STAGE
#undef PG8_LDA
#undef PG8_LDB
#undef PG8_MMA
#undef PG8_WAIT_V
#undef PG8_WAIT_L
#undef PG8_BAR
#undef PG8_SCHED
}
}

constexpr int DM = 1024, SEQ = 8192, NB = 2, MP = NB * SEQ, MS = 512, M = MP + MS;
constexpr int NPROJ = 1280, FF = 4096, NG = 32, NP = 64, NC = 16;
constexpr long O_YP = 0, O_YS = 16777216, O_KP = 17301504, O_VP = 17334272, O_SRP = 17367040, O_SIP = 17371136, O_KS = 17375232, O_VS = 19472384, O_SRS = 21569536, O_SIS = 21831680;
constexpr int TCH = 64, NCH = SEQ / TCH;
typedef unsigned short bf16;
typedef float f32x4 __attribute__((ext_vector_type(4)));
typedef unsigned v4u __attribute__((ext_vector_type(4)));
#define LAS __attribute__((address_space(3)))
#define GAS __attribute__((address_space(1)))

constexpr size_t MiB = 1u << 20;
constexpr size_t WS_CTL = 0;
constexpr size_t WS_WIN = 1 * MiB;
constexpr size_t WS_WOUT = 4 * MiB;
constexpr size_t WS_WUP = 6 * MiB;
constexpr size_t WS_WDN = 14 * MiB;
constexpr size_t WS_WGLU = 22 * MiB;
constexpr size_t WS_SSMP = 23 * MiB;
constexpr size_t WS_XN = 24 * MiB;
constexpr size_t WS_QKVU = 58 * MiB;
constexpr size_t WS_MERGED = 100 * MiB;
constexpr size_t WS_H = 58 * MiB;
constexpr size_t WS_OATT = 134 * MiB;
constexpr size_t WS_OSSM = 168 * MiB;
constexpr size_t WS_G = 202 * MiB;
constexpr size_t WS_SLOC = 220 * MiB;
constexpr size_t WS_END = 256 * MiB;

__device__ __forceinline__ unsigned f2bf(float f) { unsigned u = __builtin_bit_cast(unsigned, f); return (u + 0x7fffu + ((u >> 16) & 1u)) >> 16; }
__device__ __forceinline__ unsigned pk2(float lo, float hi) { return f2bf(lo) | (f2bf(hi) << 16); }
__device__ __forceinline__ float bf2f(bf16 b) { return __uint_as_float((unsigned)b << 16); }
__device__ __forceinline__ float wave_sum(float v) {
#pragma unroll
    for (int o = 1; o < 64; o <<= 1) v += __shfl_xor(v, o);
    return v;
}

__device__ __forceinline__ void p0_transpose_item(const float* W, int K, int N, bf16* WT, LAS float* scr, int item, int lane) {
    const int nblk = N / 32, kb = item / nblk, nb = item % nblk, k0 = 64 * kb, n0 = 32 * nb;
#pragma unroll 8
    for (int i = 0; i < 32; ++i) { const int kk = 2 * i + (lane >> 5); scr[kk * 33 + (lane & 31)] = W[(size_t)(k0 + kk) * N + n0 + (lane & 31)]; }
    asm volatile("s_waitcnt lgkmcnt(0)" ::: "memory");
    const int c = lane & 7;
#pragma unroll
    for (int j = 0; j < 4; ++j) { const int n = (lane >> 3) + 8 * j; const LAS float* s = scr + (8 * c) * 33 + n;
        v4u o; o.x = pk2(s[0 * 33], s[1 * 33]); o.y = pk2(s[2 * 33], s[3 * 33]); o.z = pk2(s[4 * 33], s[5 * 33]); o.w = pk2(s[6 * 33], s[7 * 33]);
        *(v4u*)(WT + (size_t)(n0 + n) * K + k0 + 8 * c) = o; }
    asm volatile("s_waitcnt lgkmcnt(0)" ::: "memory");
}
__device__ __forceinline__ void rms_row_to_bf16(const float* xrow, const float* gain, bf16* orow, int lane) {
    const f32x4* xr = (const f32x4*)xrow + lane; const f32x4* gr = (const f32x4*)gain + lane;
    f32x4 v[4]; float s = 0.f;
#pragma unroll
    for (int j = 0; j < 4; ++j) { v[j] = xr[64 * j]; s += (v[j].x * v[j].x + v[j].y * v[j].y) + (v[j].z * v[j].z + v[j].w * v[j].w); }
    const float rstd = 1.f / sqrtf(wave_sum(s) * (1.f / 1024.f) + 1e-6f);
    unsigned long long* o8 = (unsigned long long*)orow + lane;
#pragma unroll
    for (int j = 0; j < 4; ++j) { const f32x4 g = gr[64 * j]; o8[64 * j] = (unsigned long long)pk2(v[j].x * rstd * g.x, v[j].y * rstd * g.y) | ((unsigned long long)pk2(v[j].z * rstd * g.z, v[j].w * rstd * g.w) << 32); }
}

struct In { const float* p[27]; };

__global__ void __launch_bounds__(512) k_prologue(In in, unsigned char* ws, float* out) {
    extern __shared__ __attribute__((aligned(16))) unsigned char lds[];
    const int tid = threadIdx.x, lane = tid & 63, wave = tid >> 6;
    LAS float* scr = (LAS float*)lds + wave * 64 * 33;
    const int gw = blockIdx.x * 8 + wave, NGW = gridDim.x * 8;
    constexpr int I_IN = (1024 / 64) * (1280 / 32), I_OUT = (1024 / 64) * (1024 / 32), I_UP = (1024 / 64) * (4096 / 32), I_DN = (4096 / 64) * (1024 / 32), I_GLU = (512 / 64) * (512 / 32);
    constexpr int NITEMS = I_IN + I_OUT + I_UP + I_DN + I_GLU;
    for (int it = gw; it < NITEMS; it += NGW) {
        int r = it;
        if (r < I_IN) { p0_transpose_item(in.p[8], 1024, 1280, (bf16*)(ws + WS_WIN), scr, r, lane); continue; } r -= I_IN;
        if (r < I_OUT) { p0_transpose_item(in.p[22], 1024, 1024, (bf16*)(ws + WS_WOUT), scr, r, lane); continue; } r -= I_OUT;
        if (r < I_UP) { p0_transpose_item(in.p[24], 1024, 4096, (bf16*)(ws + WS_WUP), scr, r, lane); continue; } r -= I_UP;
        if (r < I_DN) { p0_transpose_item(in.p[25], 4096, 1024, (bf16*)(ws + WS_WDN), scr, r, lane); continue; } r -= I_DN;
        p0_transpose_item(in.p[18], 512, 512, (bf16*)(ws + WS_WGLU), scr, r, lane);
    }
    bf16* XN = (bf16*)(ws + WS_XN);
    for (int m = gw; m < M; m += NGW) { const float* xr = m < MP ? in.p[0] + (size_t)m * DM : in.p[1] + (size_t)(m - MP) * DM; rms_row_to_bf16(xr, in.p[7], XN + (size_t)m * DM, lane); }
    const int gt = blockIdx.x * 512 + tid;
    if (gt < NG * NP) {
        const int g = gt / NP;
        const double step = exp((double)in.p[12][g]); const double ar = in.p[10][gt], ai = in.p[11][gt];
        const double mag = exp(ar * step), lr = mag * cos(ai * step), li = mag * sin(ai * step);
        const double magT = exp(ar * step * TCH), lTr = magT * cos(ai * step * TCH), lTi = magT * sin(ai * step * TCH);
        const double den = ar * ar + ai * ai; const double cr = ((lr - 1.0) * ar + li * ai) / den, ci = (li * ar - (lr - 1.0) * ai) / den;
        float* P = (float*)(ws + WS_SSMP);
        P[gt * 2] = (float)lr; P[gt * 2 + 1] = (float)li; P[4096 + gt * 2] = (float)lTr; P[4096 + gt * 2 + 1] = (float)lTi;
        for (int c = 0; c < NC; ++c) { const double br = in.p[13][gt * NC + c], bi = in.p[14][gt * NC + c];
            P[8192 + (gt * NC + c) * 2] = (float)(cr * br - ci * bi); P[8192 + (gt * NC + c) * 2 + 1] = (float)(cr * bi + ci * br); }
    }
    { const int nthreads = gridDim.x * 512; const int total = 128 * 124 * 32;
        for (int i = blockIdx.x * 512 + tid; i < total; i += nthreads) { const int q = i & 31, sw = i >> 5, s = sw / 124, w = sw % 124;
            const size_t src = ((size_t)(s * 128 + w + 4) * 128) / 4 + q, dst = ((size_t)(s * 128 + w) * 128) / 4 + q;
            ((f32x4*)(out + O_KS))[dst] = ((const f32x4*)in.p[2])[src]; ((f32x4*)(out + O_VS))[dst] = ((const f32x4*)in.p[3])[src]; } }
}

template <class Epi> __global__ void __launch_bounds__(512, 2) k_gemm(const bf16* A, const bf16* Bt, Epi E, int Mr, int N, int K, int pad) {
    extern __shared__ __attribute__((aligned(16))) unsigned char lds[];
    pg8::Gemm g{A, Bt, Mr, N, K}; pg8::StaticOrder S; S.init(Mr, N, (int)gridDim.x, (int)blockIdx.x);
    pg8::gemm_phase<Epi, pg8::StaticOrder, true, true>((PG8_LAS unsigned char*)lds, g, S, E);
}

__device__ __forceinline__ int rel_bucket(int n) {
    if (n < 16) return n;
    const int l = 16 + (int)(logf((float)n / 16.f) / logf(8.f) * 16.f);
    return l < 31 ? l : 31;
}

__global__ void __launch_bounds__(128) k_attn_prompt(const bf16* QKVU, const float* rel_bias, const float* sinks, float* OATT) {
    __shared__ bf16 Ks[128][64]; __shared__ bf16 Vs[128][64]; __shared__ float bias[128];
    const int n = blockIdx.x, h = blockIdx.y, b = blockIdx.z, i = threadIdx.x, g = h >> 2;
    bias[i] = rel_bias[rel_bucket(i) * 8 + h];
    const size_t qrow = (size_t)b * SEQ + n * 128 + i;
    float q[64], o[64];
#pragma unroll
    for (int d = 0; d < 64; ++d) { q[d] = bf2f(QKVU[qrow * NPROJ + h * 64 + d]) * 0.125f; o[d] = 0.f; }
    float m = sinks[h], l = 1.f;
    for (int half = (n == 0 ? 1 : 0); half < 2; ++half) {
        __syncthreads();
        const size_t krow0 = (size_t)b * SEQ + (n - 1 + half) * 128;
        for (int e = i; e < 128 * 64; e += 128) { const int r = e >> 6, d = e & 63; Ks[r][d] = QKVU[(krow0 + r) * NPROJ + 512 + g * 64 + d]; Vs[r][d] = QKVU[(krow0 + r) * NPROJ + 640 + g * 64 + d]; }
        __syncthreads();
        for (int j = 0; j < 128; ++j) {
            const int dist = i + 128 - (half * 128 + j);
            if (dist >= 0 && dist < 128) {
                float s = 0.f;
#pragma unroll
                for (int d = 0; d < 64; ++d) s += q[d] * bf2f(Ks[j][d]);
                s += bias[dist];
                const float mn = fmaxf(m, s), a = __expf(m - mn), p = __expf(s - mn);
                l = l * a + p; m = mn;
#pragma unroll
                for (int d = 0; d < 64; ++d) o[d] = o[d] * a + p * bf2f(Vs[j][d]);
            }
        }
    }
    const float inv = 1.f / l;
#pragma unroll
    for (int d = 0; d < 64; ++d) OATT[qrow * 512 + h * 64 + d] = o[d] * inv;
}
__global__ void __launch_bounds__(64) k_attn_sample(const bf16* QKVU, const float* ck, const float* cv, const float* rel_bias, const float* sinks, float* OATT) {
    const int s = blockIdx.x, tid = threadIdx.x; if (tid >= 32) return;
    const int i = tid >> 3, h = tid & 7, g = h >> 2;
    const size_t qrow = (size_t)MP + s * 4 + i;
    float q[64], o[64];
#pragma unroll
    for (int d = 0; d < 64; ++d) { q[d] = bf2f(QKVU[qrow * NPROJ + h * 64 + d]) * 0.125f; o[d] = 0.f; }
    float m = sinks[h], l = 1.f;
    for (int jj = i + 1; jj <= i + 128; ++jj) {
        const int dist = i + 128 - jj;
        float kf[64], vf[64];
        if (jj < 128) { const float* kp = ck + ((size_t)(s * 128 + jj) * 2 + g) * 64; const float* vp = cv + ((size_t)(s * 128 + jj) * 2 + g) * 64;
#pragma unroll
            for (int d = 0; d < 64; ++d) { kf[d] = kp[d]; vf[d] = vp[d]; } }
        else { const size_t kr = (size_t)MP + s * 4 + (jj - 128);
#pragma unroll
            for (int d = 0; d < 64; ++d) { kf[d] = bf2f(QKVU[kr * NPROJ + 512 + g * 64 + d]); vf[d] = bf2f(QKVU[kr * NPROJ + 640 + g * 64 + d]); } }
        float sc = 0.f;
#pragma unroll
        for (int d = 0; d < 64; ++d) sc += q[d] * kf[d];
        sc += rel_bias[rel_bucket(dist) * 8 + h];
        const float mn = fmaxf(m, sc), a = __expf(m - mn), p = __expf(sc - mn);
        l = l * a + p; m = mn;
#pragma unroll
        for (int d = 0; d < 64; ++d) o[d] = o[d] * a + p * vf[d];
    }
    const float inv = 1.f / l;
#pragma unroll
    for (int d = 0; d < 64; ++d) OATT[qrow * 512 + h * 64 + d] = o[d] * inv;
}

__global__ void __launch_bounds__(64) k_ssm_local(const bf16* QKVU, const float* P, float* SLOC) {
    const int j = blockIdx.x, g = blockIdx.y, b = blockIdx.z, p = threadIdx.x, gp = g * NP + p;
    const float lr = P[gp * 2], li = P[gp * 2 + 1];
    float br[NC], bi[NC];
#pragma unroll
    for (int c = 0; c < NC; ++c) { br[c] = P[8192 + (gp * NC + c) * 2]; bi[c] = P[8192 + (gp * NC + c) * 2 + 1]; }
    float hr = 0.f, hi = 0.f;
    const size_t row0 = (size_t)b * SEQ + j * TCH;
    for (int t = 0; t < TCH; ++t) {
        const bf16* up = QKVU + (row0 + t) * NPROJ + 768 + g * NC;
        float ur = 0.f, ui = 0.f;
#pragma unroll
        for (int c = 0; c < NC; ++c) { const float u = bf2f(up[c]); ur += br[c] * u; ui += bi[c] * u; }
        const float nr = lr * hr - li * hi + ur, ni = lr * hi + li * hr + ui; hr = nr; hi = ni;
    }
    float* d = SLOC + ((size_t)((b * NCH + j) * NG + g) * NP + p) * 2; d[0] = hr; d[1] = hi;
}
__device__ __forceinline__ float gelu_tanh(float x) { const float u = 0.7978845608028654f * (x + 0.044715f * x * x * x); return 0.5f * x * (1.f + tanhf(u)); }
__global__ void __launch_bounds__(64) k_ssm_out(const bf16* QKVU, const float* P, const float* SLOC, const float* h0r, const float* h0i, const float* cre, const float* cim, const float* dd,
                                                 bf16* G, float* out, int sample, int pad) {
    __shared__ float Cr[NC][NP + 1], Ci[NC][NP + 1]; __shared__ float Hr[16][NP], Hi[16][NP];
    const int j = blockIdx.x, g = blockIdx.y, sq = blockIdx.z, p = threadIdx.x, gp = g * NP + p;
    const float lr = P[gp * 2], li = P[gp * 2 + 1], lTr = P[4096 + gp * 2], lTi = P[4096 + gp * 2 + 1];
    float br[NC], bi[NC];
#pragma unroll
    for (int c = 0; c < NC; ++c) { br[c] = P[8192 + (gp * NC + c) * 2]; bi[c] = P[8192 + (gp * NC + c) * 2 + 1]; }
    for (int c = 0; c < NC; ++c) { Cr[c][p] = cre[(g * NC + c) * NP + p]; Ci[c][p] = cim[(g * NC + c) * NP + p]; }
    float hr = 0.f, hi = 0.f; size_t row0; int T;
    if (sample) { hr = h0r[(size_t)(sq * NG + g) * NP + p]; hi = h0i[(size_t)(sq * NG + g) * NP + p]; row0 = (size_t)MP + sq * 4; T = 4; }
    else { for (int i = 0; i < j; ++i) { const float* s = SLOC + ((size_t)((sq * NCH + i) * NG + g) * NP + p) * 2; const float nr = lTr * hr - lTi * hi + s[0], ni = lTr * hi + lTi * hr + s[1]; hr = nr; hi = ni; }
        row0 = (size_t)sq * SEQ + j * TCH; T = TCH; }
    const int yc = p & 15, yt = p >> 4; const float dv = dd[g * NC + yc];
    for (int t0 = 0; t0 < T; t0 += 16) {
        const int nt = (T - t0) < 16 ? (T - t0) : 16;
        __syncthreads();
        for (int t = 0; t < nt; ++t) {
            const bf16* up = QKVU + (row0 + t0 + t) * NPROJ + 768 + g * NC;
            float ur = 0.f, ui = 0.f;
#pragma unroll
            for (int c = 0; c < NC; ++c) { const float u = bf2f(up[c]); ur += br[c] * u; ui += bi[c] * u; }
            const float nr = lr * hr - li * hi + ur, ni = lr * hi + li * hr + ui; hr = nr; hi = ni;
            Hr[t][p] = hr; Hi[t][p] = hi;
        }
        __syncthreads();
        for (int r = 0; r < 4; ++r) { const int t = r * 4 + yt; if (t < nt) {
            float y = 0.f;
            for (int pp = 0; pp < NP; ++pp) y += Hr[t][pp] * Cr[yc][pp] - Hi[t][pp] * Ci[yc][pp];
            const size_t row = row0 + t0 + t; y += dv * bf2f(QKVU[row * NPROJ + 768 + g * NC + yc]);
            G[row * 512 + g * NC + yc] = (bf16)f2bf(gelu_tanh(y)); } }
    }
    if (sample) { out[O_SRS + (size_t)(sq * NG + g) * NP + p] = hr; out[O_SIS + (size_t)(sq * NG + g) * NP + p] = hi; }
    else if (j == NCH - 1) { out[O_SRP + (size_t)(sq * NG + g) * NP + p] = hr; out[O_SIP + (size_t)(sq * NG + g) * NP + p] = hi; }
}
__global__ void __launch_bounds__(256) k_merge(const float* OATT, const float* OSSM, const float* ga, const float* gs, bf16* MG) {
    const int lane = threadIdx.x & 63, row = blockIdx.x * 4 + (threadIdx.x >> 6); if (row >= M) return;
#pragma unroll
    for (int part = 0; part < 2; ++part) { const float* src = (part ? OSSM : OATT) + (size_t)row * 512; const float* gn = part ? gs : ga;
        const f32x4 a = ((const f32x4*)src)[lane], b = ((const f32x4*)src)[64 + lane];
        const float ss = wave_sum((a.x * a.x + a.y * a.y) + (a.z * a.z + a.w * a.w) + (b.x * b.x + b.y * b.y) + (b.z * b.z + b.w * b.w));
        const float rstd = 1.f / sqrtf(ss * (1.f / 512.f) + 1e-6f);
        const f32x4 g0 = ((const f32x4*)gn)[lane], g1 = ((const f32x4*)gn)[64 + lane];
        unsigned long long* o8 = (unsigned long long*)(MG + (size_t)row * 1024 + part * 512);
        o8[lane] = (unsigned long long)pk2(a.x * rstd * g0.x, a.y * rstd * g0.y) | ((unsigned long long)pk2(a.z * rstd * g0.z, a.w * rstd * g0.w) << 32);
        o8[64 + lane] = (unsigned long long)pk2(b.x * rstd * g1.x, b.y * rstd * g1.y) | ((unsigned long long)pk2(b.z * rstd * g1.z, b.w * rstd * g1.w) << 32); }
}
__global__ void __launch_bounds__(256) k_rms_bf16(const float* X, const float* gain, bf16* O) {
    const int lane = threadIdx.x & 63, row = blockIdx.x * 4 + (threadIdx.x >> 6); if (row >= M) return;
    rms_row_to_bf16(X + (size_t)row * DM, gain, O + (size_t)row * DM, lane);
}
__global__ void __launch_bounds__(256) k_rms_final(float* X, const float* gain) {
    const int lane = threadIdx.x & 63, row = blockIdx.x * 4 + (threadIdx.x >> 6); if (row >= M) return;
    f32x4* xr = (f32x4*)(X + (size_t)row * DM) + lane; const f32x4* gr = (const f32x4*)gain + lane;
    f32x4 v[4]; float s = 0.f;
#pragma unroll
    for (int j = 0; j < 4; ++j) { v[j] = xr[64 * j]; s += (v[j].x * v[j].x + v[j].y * v[j].y) + (v[j].z * v[j].z + v[j].w * v[j].w); }
    const float rstd = 1.f / sqrtf(wave_sum(s) * (1.f / 1024.f) + 1e-6f);
#pragma unroll
    for (int j = 0; j < 4; ++j) xr[64 * j] = v[j] * rstd * gr[64 * j];
}

extern "C" void kernel_launch(void* const* d_in, const int* in_sizes, int n_in, void* d_out, int out_size, void* d_ws, size_t ws_size, hipStream_t stream) {
    static int ok = 0;
    if (ok == 0) {
        ok = 1;
        if (n_in != 27 || out_size != 22093824 || ws_size < WS_END) { fprintf(stderr, "kernel_launch: unexpected sizes n_in %d out %d ws %zu\n", n_in, out_size, ws_size); ok = -1; }
        (void)hipFuncSetAttribute((const void*)k_prologue, hipFuncAttributeMaxDynamicSharedMemorySize, 8 * 64 * 33 * 4);
        (void)hipFuncSetAttribute((const void*)k_gemm<pg8::EpiInProj>, hipFuncAttributeMaxDynamicSharedMemorySize, 147456);
        (void)hipFuncSetAttribute((const void*)k_gemm<pg8::EpiGlu>, hipFuncAttributeMaxDynamicSharedMemorySize, 147456);
        (void)hipFuncSetAttribute((const void*)k_gemm<pg8::EpiF32Res>, hipFuncAttributeMaxDynamicSharedMemorySize, 147456);
        (void)hipFuncSetAttribute((const void*)k_gemm<pg8::EpiRelu2>, hipFuncAttributeMaxDynamicSharedMemorySize, 147456);
    }
    if (ok < 0) return;
    In in{}; for (int i = 0; i < 27; ++i) in.p[i] = (const float*)d_in[i];
    unsigned char* ws = (unsigned char*)d_ws; float* out = (float*)d_out;
    bf16 *XN = (bf16*)(ws + WS_XN), *QKVU = (bf16*)(ws + WS_QKVU), *MG = (bf16*)(ws + WS_MERGED), *H = (bf16*)(ws + WS_H), *G = (bf16*)(ws + WS_G);
    float *OATT = (float*)(ws + WS_OATT), *OSSM = (float*)(ws + WS_OSSM), *SLOC = (float*)(ws + WS_SLOC), *P = (float*)(ws + WS_SSMP);
    const int LDSB = 147456;
    k_prologue<<<256, 512, 8 * 64 * 33 * 4, stream>>>(in, ws, out);
    k_gemm<pg8::EpiInProj><<<256, 512, LDSB, stream>>>(XN, (const bf16*)(ws + WS_WIN), pg8::EpiInProj{QKVU, out, NPROJ, 0}, M, NPROJ, DM, 0);
    k_attn_prompt<<<dim3(64, 8, 2), 128, 0, stream>>>(QKVU, in.p[6], in.p[9], OATT);
    k_attn_sample<<<128, 64, 0, stream>>>(QKVU, in.p[2], in.p[3], in.p[6], in.p[9], OATT);
    k_ssm_local<<<dim3(NCH, NG, NB), 64, 0, stream>>>(QKVU, P, SLOC);
    k_ssm_out<<<dim3(NCH, NG, NB), 64, 0, stream>>>(QKVU, P, SLOC, in.p[4], in.p[5], in.p[15], in.p[16], in.p[17], G, out, 0, 0);
    k_ssm_out<<<dim3(1, NG, 128), 64, 0, stream>>>(QKVU, P, SLOC, in.p[4], in.p[5], in.p[15], in.p[16], in.p[17], G, out, 1, 0);
    k_gemm<pg8::EpiGlu><<<256, 512, LDSB, stream>>>(G, (const bf16*)(ws + WS_WGLU), pg8::EpiGlu{G, in.p[19], OSSM, 512, 0}, M, 512, 512, 0);
    k_merge<<<(M + 3) / 4, 256, 0, stream>>>(OATT, OSSM, in.p[20], in.p[21], MG);
    k_gemm<pg8::EpiF32Res><<<256, 512, LDSB, stream>>>(MG, (const bf16*)(ws + WS_WOUT), pg8::EpiF32Res{in.p[0], in.p[1], out, DM, 0}, M, DM, DM, 0);
    k_rms_bf16<<<(M + 3) / 4, 256, 0, stream>>>(out, in.p[23], XN);
    k_gemm<pg8::EpiRelu2><<<256, 512, LDSB, stream>>>(XN, (const bf16*)(ws + WS_WUP), pg8::EpiRelu2{H, FF, 0}, M, FF, DM, 0);
    k_gemm<pg8::EpiF32Res><<<256, 512, LDSB, stream>>>(H, (const bf16*)(ws + WS_WDN), pg8::EpiF32Res{out, out + (size_t)MP * DM, out, DM, 0}, M, DM, FF, 0);
    k_rms_final<<<(M + 3) / 4, 256, 0, stream>>>(out, in.p[26]);
}
```

```cpp
#include <hip/hip_runtime.h>
#include <cstdio>
#include <cstdint>
namespace pg8 {
#define PG8_LAS __attribute__((address_space(3)))
typedef unsigned short bf16_t;
typedef short bf16x8 __attribute__((ext_vector_type(8)));
typedef float f32x4 __attribute__((ext_vector_type(4)));
typedef unsigned u32x4 __attribute__((ext_vector_type(4)));
constexpr int BM = 256, BK = 64, HALF = 128, HTB = HALF * BK * 2  , STAGE_BYTES = 8 * HTB, NXCD = 8, WGM = 8;

__host__ __device__ __forceinline__ int lds_byte(int r, int c) { const int st = (r >> 4) * 2 + (c >> 5), rr = r & 15, cc = c & 31, ob = rr * 64 + cc * 2; return st * 1024 + (ob ^ (((ob >> 9) & 1) << 5)); }
__host__ __device__ __forceinline__ void stage_rc(int b, int& R, int& C) { const int st = b / 1024, sb = b % 1024, swz = sb ^ (((sb >> 9) & 1) << 5); R = (st >> 1) * 16 + swz / 64; C = (st & 1) * 32 + (swz % 64) / 2; }
__host__ __device__ __forceinline__ int perm32(int rho) { const int n = rho >> 4, i = rho & 15; return 8 * (i >> 2) + 4 * n + (i & 3); }

struct Unit { int pm, pn; };
struct Gemm { const bf16_t* A; const bf16_t* Bt; int M, N, K; };

struct StaticOrder {
    int nM, nN, nwg, G, c;
    __host__ __device__ void init(int M, int N, int G_, int c_) { nM = M / BM; nN = N / BM; nwg = nM * nN; G = G_; c = c_; }
    __host__ __device__ bool next(int i, Unit& u) const {
        const long L = (long)i * G + c; if (L >= nwg) return false;
        int wgid = (int)L; { const int q = nwg / NXCD, r = nwg % NXCD, xcd = wgid % NXCD, off = wgid / NXCD; wgid = (xcd < r ? xcd * (q + 1) : r * (q + 1) + (xcd - r) * q) + off; }
        const int nig = WGM * nN, gid = wgid / nig, fm = gid * WGM, gsz = (nM - fm) < WGM ? (nM - fm) : WGM;
        u.pm = fm + ((wgid % nig) % gsz); u.pn = (wgid % nig) / gsz; return true;
    }
    __device__ __forceinline__ void a_ready(const Unit&) const {}
    __device__ __forceinline__ void done(const Unit&) const {}
};


__device__ __forceinline__ unsigned cvt_pk_bf16(float lo, float hi) { unsigned r; asm volatile("v_cvt_pk_bf16_f32 %0, %1, %2" : "=v"(r) : "v"(lo), "v"(hi)); return r; }

struct EpiInProj {
    static constexpr bool PERM = true, AFTER_DRAIN = false;
    bf16_t* O; float* out; int ldc; int pad;
    __device__ __forceinline__ void operator()(const f32x4 (&acc)[2][2][4][2], const Unit& u, int wr, int wc, int fr, int fq) const {
        const int row0 = u.pm * BM + wr * 64 + fr; const int col0 = u.pn * BM + wc * 32 + 8 * fq;
#pragma unroll
        for (int ai = 0; ai < 2; ++ai)
#pragma unroll
            for (int m = 0; m < 4; ++m) { const int row = row0 + ai * HALF + m * 16; bf16_t* rowp = O + (size_t)row * ldc + col0;
#pragma unroll
                for (int bj = 0; bj < 2; ++bj) { const f32x4 v0 = acc[ai][bj][m][0], v1 = acc[ai][bj][m][1];
                    u32x4 w; w.x = cvt_pk_bf16(v0[0], v0[1]); w.y = cvt_pk_bf16(v0[2], v0[3]); w.z = cvt_pk_bf16(v1[0], v1[1]); w.w = cvt_pk_bf16(v1[2], v1[3]);
                    *(u32x4*)(rowp + bj * HALF) = w; }
                if (u.pn == 2) {
                    long dst = -1;
                    if (row < 16384) { const int t = row & 8191, b = row >> 13; if (t >= 8192 - 128) dst = (long)(b * 128 + (t - (8192 - 128))) * 128; }
                    else { const int si = row - 16384; dst = (long)((si >> 2) * 128 + 124 + (si & 3)) * 128; }
                    if (dst >= 0) { const int kc = wc * 32 + 8 * fq;
                        float* kd = out + (row < 16384 ? 17301504L : 17375232L) + dst + kc;
                        float* vd = out + (row < 16384 ? 17334272L : 19472384L) + dst + kc;
                        *(f32x4*)(kd) = acc[ai][0][m][0]; *(f32x4*)(kd + 4) = acc[ai][0][m][1];
                        *(f32x4*)(vd) = acc[ai][1][m][0]; *(f32x4*)(vd + 4) = acc[ai][1][m][1]; }
                }
            }
    }
};
struct EpiF32Res {
    static constexpr bool PERM = false, AFTER_DRAIN = false;
    const float* b0; const float* b1; float* O; int ldc; int pad;
    __device__ __forceinline__ void operator()(const f32x4 (&acc)[2][2][4][2], const Unit& u, int wr, int wc, int fr, int fq) const {
        const int row0 = u.pm * BM + wr * 64 + fr; const int col0 = u.pn * BM + wc * 32 + 4 * fq;
#pragma unroll
        for (int ai = 0; ai < 2; ++ai)
#pragma unroll
            for (int m = 0; m < 4; ++m) { const int row = row0 + ai * HALF + m * 16;
                const float* bp = (row < 16384 ? b0 + (size_t)row * ldc : b1 + (size_t)(row - 16384) * ldc) + col0; float* op = O + (size_t)row * ldc + col0;
#pragma unroll
                for (int bj = 0; bj < 2; ++bj)
#pragma unroll
                    for (int n = 0; n < 2; ++n) { const f32x4 bs = *(const f32x4*)(bp + bj * HALF + n * 16); *(f32x4*)(op + bj * HALF + n * 16) = bs + acc[ai][bj][m][n]; }
            }
    }
};
struct EpiRelu2 {
    static constexpr bool PERM = true, AFTER_DRAIN = false;
    bf16_t* O; int ldc; int pad;
    __device__ __forceinline__ void operator()(const f32x4 (&acc)[2][2][4][2], const Unit& u, int wr, int wc, int fr, int fq) const {
        const int row0 = u.pm * BM + wr * 64 + fr; const int col0 = u.pn * BM + wc * 32 + 8 * fq;
#pragma unroll
        for (int ai = 0; ai < 2; ++ai)
#pragma unroll
            for (int m = 0; m < 4; ++m) { bf16_t* rowp = O + (size_t)(row0 + ai * HALF + m * 16) * ldc + col0;
#pragma unroll
                for (int bj = 0; bj < 2; ++bj) { f32x4 v0 = acc[ai][bj][m][0], v1 = acc[ai][bj][m][1];
#pragma unroll
                    for (int j = 0; j < 4; ++j) { const float a = fmaxf(v0[j], 0.f), b = fmaxf(v1[j], 0.f); v0[j] = a * a; v1[j] = b * b; }
                    u32x4 w; w.x = cvt_pk_bf16(v0[0], v0[1]); w.y = cvt_pk_bf16(v0[2], v0[3]); w.z = cvt_pk_bf16(v1[0], v1[1]); w.w = cvt_pk_bf16(v1[2], v1[3]);
                    *(u32x4*)(rowp + bj * HALF) = w; } }
    }
};
__device__ __forceinline__ float bf2f(bf16_t b) { return __uint_as_float((unsigned)b << 16); }
struct EpiGlu {
    static constexpr bool PERM = false, AFTER_DRAIN = false;
    const bf16_t* G; const float* bias; float* O; int ldc; int pad;
    __device__ __forceinline__ void operator()(const f32x4 (&acc)[2][2][4][2], const Unit& u, int wr, int wc, int fr, int fq) const {
        const int row0 = u.pm * BM + wr * 64 + fr; const int col0 = u.pn * BM + wc * 32 + 4 * fq;
#pragma unroll
        for (int ai = 0; ai < 2; ++ai)
#pragma unroll
            for (int m = 0; m < 4; ++m) { const size_t ro = (size_t)(row0 + ai * HALF + m * 16) * ldc + col0;
#pragma unroll
                for (int bj = 0; bj < 2; ++bj)
#pragma unroll
                    for (int n = 0; n < 2; ++n) { const int co = bj * HALF + n * 16; const f32x4 bv = *(const f32x4*)(bias + col0 + co);
                        const unsigned long long gw = *(const unsigned long long*)(G + ro + co); f32x4 o;
#pragma unroll
                        for (int j = 0; j < 4; ++j) { const float g = bf2f((bf16_t)(gw >> (16 * j))); const float z = acc[ai][bj][m][n][j] + bv[j]; o[j] = g / (1.f + __expf(-z)); }
                        *(f32x4*)(O + ro + co) = o; }
            }
    }
};
template <class Epi, class Sched, bool ALIGN_EPI = false, bool SP2 = false>
__device__ __forceinline__ void gemm_phase(PG8_LAS unsigned char* lds, const Gemm g, const Sched& S, const Epi& E) {
    const int tid = threadIdx.x, wid = __builtin_amdgcn_readfirstlane(tid >> 6), lane = tid & 63, wr = wid >> 2, wc = wid & 3, fr = lane & 15, fq = lane >> 4;
    const int K = g.K, nt = K / BK;
    unsigned voffA[2], voffB[2];
#pragma unroll
    for (int i = 0; i < 2; ++i) { int R, C; stage_rc(tid * 16 + i * 8192, R, C); const int Rb = Epi::PERM ? ((R & ~31) + perm32(R & 31)) : R;
        voffA[i] = (unsigned)(R * K + C) * 2u; voffB[i] = (unsigned)(Rb * K + C) * 2u; }
    const size_t kstep = (size_t)(BK * 2);
    const size_t hstep = (size_t)HALF * K * 2;
    const size_t tstep = 2 * hstep;
    const unsigned ldsw = (unsigned)wid * 1024u;
    const int aoff = lds_byte(wr * 64 + fr, fq * 8), boff = lds_byte(wc * 32 + fr, fq * 8);
#define PG8_SA(b, h) (((b) * 2 + (h)) * HTB)
#define PG8_SB(b, h) ((4 + (b) * 2 + (h)) * HTB)
#define PG8_STAGE(bufoff, gbase, voff) do { _Pragma("unroll") for (int _i = 0; _i < 2; ++_i) \
        __builtin_amdgcn_global_load_lds((const unsigned*)((const char*)(gbase) + (voff)[_i]), (PG8_LAS unsigned*)(lds + (bufoff) + ldsw + _i * 8192), 16, 0, 0); } while (0)
#define PG8_LDA(dst, b, h) do { _Pragma("unroll") for (int m = 0; m < 4; ++m) _Pragma("unroll") for (int k = 0; k < 2; ++k) dst[m][k] = *(const PG8_LAS bf16x8*)(lds + PG8_SA(b, h) + aoff + m * 2048 + k * 1024); } while (0)
#define PG8_LDB(dst, b, h) do { _Pragma("unroll") for (int n = 0; n < 2; ++n) _Pragma("unroll") for (int k = 0; k < 2; ++k) dst[n][k] = *(const PG8_LAS bf16x8*)(lds + PG8_SB(b, h) + boff + n * 2048 + k * 1024); } while (0)
#define PG8_MMA(ai, bj, At, Bt) do { __builtin_amdgcn_s_setprio(1); _Pragma("unroll") for (int m = 0; m < 4; ++m) _Pragma("unroll") for (int n = 0; n < 2; ++n) _Pragma("unroll") for (int k = 0; k < 2; ++k) \
        acc[ai][bj][m][n] = __builtin_amdgcn_mfma_f32_16x16x32_bf16(Bt[n][k], At[m][k], acc[ai][bj][m][n], 0, 0, 0); __builtin_amdgcn_s_setprio(0); } while (0)
#define PG8_WAIT_V(n) asm volatile("s_waitcnt vmcnt(" #n ")" ::: "memory")
#define PG8_WAIT_L(n) asm volatile("s_waitcnt lgkmcnt(" #n ")" ::: "memory")
#define PG8_BAR __builtin_amdgcn_s_barrier()
#define PG8_SCHED __builtin_amdgcn_sched_barrier(0)
    Unit cur, nxt; int ui = 0;
    if (!S.next(0, cur)) return;
    f32x4 acc[2][2][4][2];
#pragma unroll
    for (int a = 0; a < 2; ++a)
#pragma unroll
        for (int b = 0; b < 2; ++b)
#pragma unroll
            for (int m = 0; m < 4; ++m)
#pragma unroll
                for (int n = 0; n < 2; ++n) acc[a][b][m][n] = (f32x4){0.f, 0.f, 0.f, 0.f};
    bf16x8 At[4][2], B0[2][2], B1[2][2];
    const char* cA = (const char*)g.A + (size_t)cur.pm * tstep; const char* cB = (const char*)g.Bt + (size_t)cur.pn * tstep;
    S.a_ready(cur);
    if constexpr (SP2) {
        PG8_STAGE(PG8_SB(0, 0), cB, voffB); PG8_STAGE(PG8_SB(0, 1), cB + hstep, voffB); PG8_STAGE(PG8_SA(0, 0), cA, voffA); PG8_STAGE(PG8_SA(0, 1), cA + hstep, voffA);
        if (wr == 1) PG8_BAR;
        PG8_WAIT_V(2); PG8_BAR;
        PG8_STAGE(PG8_SB(1, 0), cB + kstep, voffB); PG8_STAGE(PG8_SA(1, 0), cA + kstep, voffA); PG8_STAGE(PG8_SB(1, 1), cB + hstep + kstep, voffB);
        PG8_WAIT_V(6); PG8_BAR;
    } else {
        PG8_STAGE(PG8_SB(0, 0), cB, voffB); PG8_STAGE(PG8_SA(0, 0), cA, voffA); PG8_STAGE(PG8_SB(0, 1), cB + hstep, voffB); PG8_STAGE(PG8_SA(0, 1), cA + hstep, voffA);
        if (wr == 1) PG8_BAR;
        PG8_WAIT_V(4); PG8_BAR;
        PG8_STAGE(PG8_SB(1, 0), cB + kstep, voffB); PG8_STAGE(PG8_SA(1, 0), cA + kstep, voffA); PG8_STAGE(PG8_SB(1, 1), cB + hstep + kstep, voffB);
        PG8_WAIT_V(6); PG8_BAR;
    }
    for (;;) {
        const bool has_next = S.next(ui + 1, nxt);
        const char* nA = has_next ? (const char*)g.A + (size_t)nxt.pm * tstep : cA; const char* nB = has_next ? (const char*)g.Bt + (size_t)nxt.pn * tstep : cB;
        for (int t = 0; t < nt; t += 2) {
            const bool last = (t == nt - 2);
            const char* a1 = cA + (size_t)(t + 1) * kstep;
            const char* a2 = last ? nA : cA + (size_t)(t + 2) * kstep; const char* b2 = last ? nB : cB + (size_t)(t + 2) * kstep;
            const char* a3 = a2 + kstep; const char* b3 = b2 + kstep;
            if (last && has_next) S.a_ready(nxt);
            if constexpr (SP2) {
            PG8_LDB(B0, 0, 0); PG8_LDB(B1, 0, 1); PG8_SCHED; PG8_LDA(At, 0, 0); PG8_STAGE(PG8_SA(1, 1), a1 + hstep, voffA);
            PG8_WAIT_V(8); PG8_WAIT_L(0); PG8_BAR; PG8_MMA(0, 0, At, B0); PG8_MMA(0, 1, At, B1); PG8_BAR; PG8_SCHED;
            PG8_LDA(At, 0, 1); PG8_STAGE(PG8_SB(0, 0), b2, voffB); PG8_STAGE(PG8_SB(0, 1), b2 + hstep, voffB); PG8_STAGE(PG8_SA(0, 0), a2, voffA);
            PG8_WAIT_V(8); PG8_WAIT_L(0); PG8_BAR; PG8_MMA(1, 0, At, B0); PG8_MMA(1, 1, At, B1); PG8_BAR; PG8_SCHED;
            PG8_LDB(B0, 1, 0); PG8_LDB(B1, 1, 1); PG8_SCHED; PG8_LDA(At, 1, 0); PG8_STAGE(PG8_SA(0, 1), a2 + hstep, voffA);
            PG8_WAIT_V(8); PG8_WAIT_L(0); PG8_BAR; PG8_MMA(0, 0, At, B0); PG8_MMA(0, 1, At, B1); PG8_BAR; PG8_SCHED;
            PG8_LDA(At, 1, 1); PG8_STAGE(PG8_SB(1, 0), b3, voffB); PG8_STAGE(PG8_SB(1, 1), b3 + hstep, voffB); PG8_STAGE(PG8_SA(1, 0), a3, voffA);
            PG8_WAIT_V(8); PG8_WAIT_L(0); PG8_BAR; PG8_MMA(1, 0, At, B0); PG8_MMA(1, 1, At, B1); PG8_BAR; PG8_SCHED;
            } else {
            PG8_LDB(B0, 0, 0); PG8_SCHED; PG8_LDA(At, 0, 0); PG8_STAGE(PG8_SA(1, 1), a1 + hstep, voffA);
            PG8_WAIT_L(8); PG8_BAR; PG8_WAIT_L(0); PG8_MMA(0, 0, At, B0); PG8_BAR; PG8_SCHED;
            PG8_LDB(B1, 0, 1); PG8_STAGE(PG8_SB(0, 0), b2, voffB);
            PG8_BAR; PG8_WAIT_L(0); PG8_MMA(0, 1, At, B1); PG8_BAR;
            PG8_LDA(At, 0, 1); PG8_STAGE(PG8_SA(0, 0), a2, voffA);
            PG8_BAR; PG8_WAIT_L(0); PG8_MMA(1, 0, At, B0); PG8_BAR; PG8_SCHED;
            PG8_STAGE(PG8_SB(0, 1), b2 + hstep, voffB);
            PG8_WAIT_V(6); PG8_BAR; PG8_MMA(1, 1, At, B1); PG8_BAR;
            PG8_LDB(B0, 1, 0); PG8_SCHED; PG8_LDA(At, 1, 0); PG8_STAGE(PG8_SA(0, 1), a2 + hstep, voffA);
            PG8_WAIT_L(8); PG8_BAR; PG8_WAIT_L(0); PG8_MMA(0, 0, At, B0); PG8_BAR; PG8_SCHED;
            PG8_LDB(B1, 1, 1); PG8_STAGE(PG8_SB(1, 0), b3, voffB);
            PG8_BAR; PG8_WAIT_L(0); PG8_MMA(0, 1, At, B1); PG8_BAR;
            PG8_LDA(At, 1, 1); PG8_STAGE(PG8_SA(1, 0), a3, voffA);
            PG8_BAR; PG8_WAIT_L(0); PG8_MMA(1, 0, At, B0); PG8_BAR; PG8_SCHED;
            PG8_STAGE(PG8_SB(1, 1), b3 + hstep, voffB);
            PG8_WAIT_V(6); PG8_BAR; PG8_MMA(1, 1, At, B1); PG8_BAR;
            }
        }
        if constexpr (ALIGN_EPI) { if (wr == 0) PG8_BAR; }
        if constexpr (!Epi::AFTER_DRAIN) { E(acc, cur, wr, wc, fr, fq); S.done(cur); }
        if (!has_next) break;
#pragma unroll
        for (int a = 0; a < 2; ++a)
#pragma unroll
            for (int b = 0; b < 2; ++b)
#pragma unroll
                for (int m = 0; m < 4; ++m)
#pragma unroll
                    for (int n = 0; n < 2; ++n) acc[a][b][m][n] = (f32x4){0.f, 0.f, 0.f, 0.f};
        cur = nxt; cA = nA; cB = nB; ++ui;
        if constexpr (ALIGN_EPI) { if (wr == 1) PG8_BAR; }
    }
    PG8_WAIT_V(0);
    if constexpr (!ALIGN_EPI) { if (wr == 0) PG8_BAR; }
    PG8_BAR;
    if constexpr (Epi::AFTER_DRAIN) { E.fused(acc, cur, wr, wc, fr, fq, lds, wid, lane); S.done(cur); }
#undef PG8_SA
#undef PG8_SB
#undef PG8_STAGE
#undef PG8_LDA
#undef PG8_LDB
#undef PG8_MMA
#undef PG8_WAIT_V
#undef PG8_WAIT_L
#undef PG8_BAR
#undef PG8_SCHED
}
}

constexpr int DM = 1024, SEQ = 8192, NB = 2, MP = NB * SEQ, MS = 512, M = MP + MS;
constexpr int NPROJ = 1280, FF = 4096, NG = 32, NP = 64, NC = 16;
constexpr long O_YP = 0, O_YS = 16777216, O_KP = 17301504, O_VP = 17334272, O_SRP = 17367040, O_SIP = 17371136, O_KS = 17375232, O_VS = 19472384, O_SRS = 21569536, O_SIS = 21831680;
constexpr int TCH = 64, NCH = SEQ / TCH;
typedef unsigned short bf16;
typedef float f32x4 __attribute__((ext_vector_type(4)));
typedef unsigned v4u __attribute__((ext_vector_type(4)));
#define LAS __attribute__((address_space(3)))
#define GAS __attribute__((address_space(1)))

constexpr size_t MiB = 1u << 20;
constexpr size_t WS_CTL = 0;
constexpr size_t WS_WIN = 1 * MiB;
constexpr size_t WS_WOUT = 4 * MiB;
constexpr size_t WS_WUP = 6 * MiB;
constexpr size_t WS_WDN = 14 * MiB;
constexpr size_t WS_WGLU = 22 * MiB;
constexpr size_t WS_SSMP = 23 * MiB;
constexpr size_t WS_XN = 24 * MiB;
constexpr size_t WS_QKVU = 58 * MiB;
constexpr size_t WS_MERGED = 100 * MiB;
constexpr size_t WS_H = 58 * MiB;
constexpr size_t WS_OATT = 134 * MiB;
constexpr size_t WS_OSSM = 168 * MiB;
constexpr size_t WS_G = 202 * MiB;
constexpr size_t WS_SLOC = 220 * MiB;
constexpr size_t WS_END = 256 * MiB;

__device__ __forceinline__ unsigned f2bf(float f) { unsigned u = __builtin_bit_cast(unsigned, f); return (u + 0x7fffu + ((u >> 16) & 1u)) >> 16; }
__device__ __forceinline__ unsigned pk2(float lo, float hi) { return f2bf(lo) | (f2bf(hi) << 16); }
__device__ __forceinline__ float bf2f(bf16 b) { return __uint_as_float((unsigned)b << 16); }
__device__ __forceinline__ float wave_sum(float v) {
#pragma unroll
    for (int o = 1; o < 64; o <<= 1) v += __shfl_xor(v, o);
    return v;
}

__device__ __forceinline__ void p0_transpose_item(const float* W, int K, int N, bf16* WT, LAS float* scr, int item, int lane) {
    const int nblk = N / 32, kb = item / nblk, nb = item % nblk, k0 = 64 * kb, n0 = 32 * nb;
#pragma unroll 8
    for (int i = 0; i < 32; ++i) { const int kk = 2 * i + (lane >> 5); scr[kk * 33 + (lane & 31)] = W[(size_t)(k0 + kk) * N + n0 + (lane & 31)]; }
    asm volatile("s_waitcnt lgkmcnt(0)" ::: "memory");
    const int c = lane & 7;
#pragma unroll
    for (int j = 0; j < 4; ++j) { const int n = (lane >> 3) + 8 * j; const LAS float* s = scr + (8 * c) * 33 + n;
        v4u o; o.x = pk2(s[0 * 33], s[1 * 33]); o.y = pk2(s[2 * 33], s[3 * 33]); o.z = pk2(s[4 * 33], s[5 * 33]); o.w = pk2(s[6 * 33], s[7 * 33]);
        *(v4u*)(WT + (size_t)(n0 + n) * K + k0 + 8 * c) = o; }
    asm volatile("s_waitcnt lgkmcnt(0)" ::: "memory");
}
__device__ __forceinline__ void rms_row_to_bf16(const float* xrow, const float* gain, bf16* orow, int lane) {
    const f32x4* xr = (const f32x4*)xrow + lane; const f32x4* gr = (const f32x4*)gain + lane;
    f32x4 v[4]; float s = 0.f;
#pragma unroll
    for (int j = 0; j < 4; ++j) { v[j] = xr[64 * j]; s += (v[j].x * v[j].x + v[j].y * v[j].y) + (v[j].z * v[j].z + v[j].w * v[j].w); }
    const float rstd = 1.f / sqrtf(wave_sum(s) * (1.f / 1024.f) + 1e-6f);
    unsigned long long* o8 = (unsigned long long*)orow + lane;
#pragma unroll
    for (int j = 0; j < 4; ++j) { const f32x4 g = gr[64 * j]; o8[64 * j] = (unsigned long long)pk2(v[j].x * rstd * g.x, v[j].y * rstd * g.y) | ((unsigned long long)pk2(v[j].z * rstd * g.z, v[j].w * rstd * g.w) << 32); }
}

#define XB_TMO      128
#define XB_XCNT(j)  (256  + 64 * (j))
#define XB_XSUB(j)  (1280 + 64 * (j))
#define XB_XGEN(j)  (2304 + 64 * (j))
#define XB_TOP      3328
#define XB_TOPGEN   3392
#define XCD_BAR_WORDS 3456
#define XB_SPIN_CAP (1u << 18)

__device__ __forceinline__ unsigned xb_ld(unsigned* p)              { return __hip_atomic_load(p, __ATOMIC_RELAXED, __HIP_MEMORY_SCOPE_AGENT); }
__device__ __forceinline__ unsigned xb_add(unsigned* p, unsigned v) { return __hip_atomic_fetch_add(p, v, __ATOMIC_RELAXED, __HIP_MEMORY_SCOPE_AGENT); }
__device__ __forceinline__ unsigned xb_xcc_id() { return (unsigned)__builtin_amdgcn_s_getreg((3 << 11) | 20) & 0xFu; }
#define XB_SPIN(cond, bar) do { unsigned _sp = 0; while (cond) { __builtin_amdgcn_s_sleep(1); \
    if ((++_sp & 255u) == 0u) { if (xb_ld(&(bar)[XB_TMO])) break; if (_sp > XB_SPIN_CAP) { atomicAdd(&(bar)[XB_TMO], 1u); break; } } } } while (0)

struct XcdBarrier {
    unsigned* bar; unsigned x;
    volatile LAS unsigned* st;
};

__device__ __forceinline__ XcdBarrier xcd_barrier_post(unsigned* bar, volatile LAS unsigned* st) {
    XcdBarrier b; b.bar = bar; b.x = xb_xcc_id(); b.st = st;
    if (threadIdx.x == 0) (void)xb_add(&bar[XB_XCNT(b.x)], 1u);
    return b;
}
__device__ __forceinline__ void xcd_barrier_complete(unsigned* bar, unsigned x, unsigned& nloc, unsigned& nx) {
    const unsigned G = gridDim.x * gridDim.y * gridDim.z;
    unsigned sum, cnt, mine, sp = 0u;
    for (;;) {
        sum = 0u; cnt = 0u; mine = 0u;
#pragma unroll
        for (unsigned j = 0; j < 16; ++j) { const unsigned c = xb_ld(&bar[XB_XCNT(j)]); sum += c; cnt += (c > 0u) ? 1u : 0u; mine = (j == x) ? c : mine; }
        if (sum == G) break;
        __builtin_amdgcn_s_sleep(1);
        if ((++sp & 255u) == 0u) { if (xb_ld(&bar[XB_TMO])) break; if (sp > XB_SPIN_CAP) { atomicAdd(&bar[XB_TMO], 1u); break; } }
    }
    nloc = mine > 0u ? mine : 1u; nx = cnt > 0u ? cnt : 1u;
}

__device__ __forceinline__ void xcd_barrier(const XcdBarrier& b) {
    asm volatile("s_waitcnt vmcnt(0)" ::: "memory");
    __syncthreads();
    if (threadIdx.x == 0) {
        unsigned* bar = b.bar;
        __builtin_amdgcn_s_waitcnt(0);
        unsigned nloc = b.st[0], nx = b.st[1];
        if (nloc == 0u) { xcd_barrier_complete(bar, b.x, nloc, nx); b.st[0] = nloc; b.st[1] = nx; }
        const unsigned old = xb_add(&bar[XB_XSUB(b.x)], 1u);
        const unsigned gen = old / nloc;
        if (old + 1u == (gen + 1u) * nloc) {
            __builtin_amdgcn_fence(__ATOMIC_RELEASE, "agent");
            asm volatile("s_waitcnt vmcnt(0)" ::: "memory");
            const unsigned og = xb_add(&bar[XB_TOP], 1u);
            const unsigned tg = og / nx;
            if (og + 1u == (tg + 1u) * nx) xb_add(&bar[XB_TOPGEN], 1u);
            else XB_SPIN(xb_ld(&bar[XB_TOPGEN]) == tg, bar);
            __builtin_amdgcn_fence(__ATOMIC_ACQUIRE, "agent");
            xb_add(&bar[XB_XGEN(b.x)], 1u);
            asm volatile("s_waitcnt vmcnt(0)" ::: "memory");
        } else {
            XB_SPIN(xb_ld(&bar[XB_XGEN(b.x)]) == gen, bar);
            __builtin_amdgcn_fence(__ATOMIC_ACQUIRE, "agent");
            asm volatile("s_waitcnt vmcnt(0)" ::: "memory");
        }
    }
    __syncthreads();
}

typedef GAS unsigned gu32;
constexpr int CW_BAR = 4096;
constexpr size_t CTL_ZERO_BYTES = 64 * 1024;
constexpr int RING_BYTES = 131072, LDSCTL_OFF = RING_BYTES, MISC_OFF = LDSCTL_OFF + 320, LDS_BYTES = 147456;
struct Args { const float* in[27]; float* out; unsigned char* ws; };

__device__ __forceinline__ int rel_bucket(int n) {
    if (n < 16) return n;
    const int l = 16 + (int)(logf((float)n / 16.f) / logf(8.f) * 16.f);
    return l < 31 ? l : 31;
}
__device__ __forceinline__ float gelu_tanh(float x) { const float u = 0.7978845608028654f * (x + 0.044715f * x * x * x); return 0.5f * x * (1.f + tanhf(u)); }

__device__ __forceinline__ void phase_prologue(const Args& a, LAS unsigned char* L, int tid, int lane, int wave, int bx, int G) {
    unsigned char* ws = a.ws;
    LAS float* scr = (LAS float*)L + wave * 64 * 33;
    const int gw = bx * 8 + wave, NGW = G * 8;
    constexpr int I_IN = (1024 / 64) * (1280 / 32), I_OUT = (1024 / 64) * (1024 / 32), I_UP = (1024 / 64) * (4096 / 32), I_DN = (4096 / 64) * (1024 / 32), I_GLU = (512 / 64) * (512 / 32);
    constexpr int NITEMS = I_IN + I_OUT + I_UP + I_DN + I_GLU;
    for (int it = gw; it < NITEMS; it += NGW) {
        int r = it;
        if (r < I_IN) { p0_transpose_item(a.in[8], 1024, 1280, (bf16*)(ws + WS_WIN), scr, r, lane); continue; } r -= I_IN;
        if (r < I_OUT) { p0_transpose_item(a.in[22], 1024, 1024, (bf16*)(ws + WS_WOUT), scr, r, lane); continue; } r -= I_OUT;
        if (r < I_UP) { p0_transpose_item(a.in[24], 1024, 4096, (bf16*)(ws + WS_WUP), scr, r, lane); continue; } r -= I_UP;
        if (r < I_DN) { p0_transpose_item(a.in[25], 4096, 1024, (bf16*)(ws + WS_WDN), scr, r, lane); continue; } r -= I_DN;
        p0_transpose_item(a.in[18], 512, 512, (bf16*)(ws + WS_WGLU), scr, r, lane);
    }
    bf16* XN = (bf16*)(ws + WS_XN);
    for (int m = gw; m < M; m += NGW) { const float* xr = m < MP ? a.in[0] + (size_t)m * DM : a.in[1] + (size_t)(m - MP) * DM; rms_row_to_bf16(xr, a.in[7], XN + (size_t)m * DM, lane); }
    const int gt = bx * 512 + tid;
    if (gt < NG * NP) {
        const int g = gt / NP;
        const double step = exp((double)a.in[12][g]); const double ar = a.in[10][gt], ai = a.in[11][gt];
        const double mag = exp(ar * step), lr = mag * cos(ai * step), li = mag * sin(ai * step);
        const double magT = exp(ar * step * TCH), lTr = magT * cos(ai * step * TCH), lTi = magT * sin(ai * step * TCH);
        const double den = ar * ar + ai * ai; const double cr = ((lr - 1.0) * ar + li * ai) / den, ci = (li * ar - (lr - 1.0) * ai) / den;
        float* P = (float*)(ws + WS_SSMP);
        P[gt * 2] = (float)lr; P[gt * 2 + 1] = (float)li; P[4096 + gt * 2] = (float)lTr; P[4096 + gt * 2 + 1] = (float)lTi;
        for (int c = 0; c < NC; ++c) { const double br = a.in[13][gt * NC + c], bi = a.in[14][gt * NC + c];
            P[8192 + (gt * NC + c) * 2] = (float)(cr * br - ci * bi); P[8192 + (gt * NC + c) * 2 + 1] = (float)(cr * bi + ci * br); }
    }
    { const int nthreads = G * 512; const int total = 128 * 124 * 32;
        for (int i = bx * 512 + tid; i < total; i += nthreads) { const int q = i & 31, sw = i >> 5, s = sw / 124, w = sw % 124;
            const size_t src = ((size_t)(s * 128 + w + 4) * 128) / 4 + q, dst = ((size_t)(s * 128 + w) * 128) / 4 + q;
            ((f32x4*)(a.out + O_KS))[dst] = ((const f32x4*)a.in[2])[src]; ((f32x4*)(a.out + O_VS))[dst] = ((const f32x4*)a.in[3])[src]; } }
}

__device__ __forceinline__ void phase_attn_prompt_simple(const Args& a, LAS unsigned char* L, int tid, int bx, int G) {
    const bf16* QKVU = (const bf16*)(a.ws + WS_QKVU); float* OATT = (float*)(a.ws + WS_OATT);
    LAS bf16* Ks = (LAS bf16*)L; LAS bf16* Vs = (LAS bf16*)(L + 16384); LAS float* bias = (LAS float*)(L + 32768);
    const int sb = tid >> 7, i = tid & 127;
    for (int it = bx; it < 256; it += G) {
        const int hq = it & 1, n = (it >> 1) & 63, b = it >> 7, h = hq * 4 + sb, g = hq;
        __syncthreads();
        bias[sb * 128 + i] = a.in[6][rel_bucket(i) * 8 + h];
        const size_t qrow = (size_t)b * SEQ + n * 128 + i;
        float q[64], o[64];
#pragma unroll
        for (int d = 0; d < 64; ++d) { q[d] = bf2f(QKVU[qrow * NPROJ + h * 64 + d]) * 0.125f; o[d] = 0.f; }
        float m = a.in[9][h], l = 1.f;
        for (int half = (n == 0 ? 1 : 0); half < 2; ++half) {
            __syncthreads();
            const size_t krow0 = (size_t)b * SEQ + (n - 1 + half) * 128;
            for (int e = tid; e < 128 * 64; e += 512) { const int r = e >> 6, d = e & 63; Ks[r * 64 + d] = QKVU[(krow0 + r) * NPROJ + 512 + g * 64 + d]; Vs[r * 64 + d] = QKVU[(krow0 + r) * NPROJ + 640 + g * 64 + d]; }
            __syncthreads();
            for (int j = 0; j < 128; ++j) {
                const int dist = i + 128 - (half * 128 + j);
                if (dist >= 0 && dist < 128) {
                    float s = 0.f;
#pragma unroll
                    for (int d = 0; d < 64; ++d) s += q[d] * bf2f(Ks[j * 64 + d]);
                    s += bias[sb * 128 + dist];
                    const float mn = fmaxf(m, s), al = __expf(m - mn), p = __expf(s - mn);
                    l = l * al + p; m = mn;
#pragma unroll
                    for (int d = 0; d < 64; ++d) o[d] = o[d] * al + p * bf2f(Vs[j * 64 + d]);
                }
            }
        }
        const float inv = 1.f / l;
#pragma unroll
        for (int d = 0; d < 64; ++d) OATT[qrow * 512 + h * 64 + d] = o[d] * inv;
    }
    __syncthreads();
}
__device__ __forceinline__ void phase_attn_sample(const Args& a, int lane, int gw, int NGW) {
    const bf16* QKVU = (const bf16*)(a.ws + WS_QKVU); float* OATT = (float*)(a.ws + WS_OATT);
    const float* ck = a.in[2]; const float* cv = a.in[3];
    for (int it = gw; it < 128 * 4 * 8; it += NGW) {
        const int h = it & 7, i = (it >> 3) & 3, s = it >> 5, g = h >> 2;
        const size_t qrow = (size_t)MP + s * 4 + i;
        const float q = bf2f(QKVU[qrow * NPROJ + h * 64 + lane]) * 0.125f;
        float m = a.in[9][h], l = 1.f, o = 0.f;
        for (int jj = i + 1; jj <= i + 128; ++jj) {
            float kv, vv;
            if (jj < 128) { kv = ck[((size_t)(s * 128 + jj) * 2 + g) * 64 + lane]; vv = cv[((size_t)(s * 128 + jj) * 2 + g) * 64 + lane]; }
            else { const size_t kr = (size_t)MP + s * 4 + (jj - 128); kv = bf2f(QKVU[kr * NPROJ + 512 + g * 64 + lane]); vv = bf2f(QKVU[kr * NPROJ + 640 + g * 64 + lane]); }
            const float sc = wave_sum(q * kv) + a.in[6][rel_bucket(i + 128 - jj) * 8 + h];
            const float mn = fmaxf(m, sc), al = __expf(m - mn), p = __expf(sc - mn);
            l = l * al + p; m = mn; o = o * al + p * vv;
        }
        OATT[qrow * 512 + h * 64 + lane] = o / l;
    }
}
__device__ __forceinline__ void phase_ssm_local(const Args& a, int lane, int gw, int NGW) {
    const bf16* QKVU = (const bf16*)(a.ws + WS_QKVU); const float* P = (const float*)(a.ws + WS_SSMP); float* SLOC = (float*)(a.ws + WS_SLOC);
    for (int it = gw; it < NB * NCH * NG; it += NGW) {
        const int g = it & 31, j = (it >> 5) & (NCH - 1), b = it >> 12, p = lane, gp = g * NP + p;
        const float lr = P[gp * 2], li = P[gp * 2 + 1];
        float br[NC], bi[NC];
#pragma unroll
        for (int c = 0; c < NC; ++c) { br[c] = P[8192 + (gp * NC + c) * 2]; bi[c] = P[8192 + (gp * NC + c) * 2 + 1]; }
        float hr = 0.f, hi = 0.f;
        const size_t row0 = (size_t)b * SEQ + j * TCH;
        for (int t = 0; t < TCH; ++t) {
            const bf16* up = QKVU + (row0 + t) * NPROJ + 768 + g * NC;
            float ur = 0.f, ui = 0.f;
#pragma unroll
            for (int c = 0; c < NC; ++c) { const float u = bf2f(up[c]); ur += br[c] * u; ui += bi[c] * u; }
            const float nr = lr * hr - li * hi + ur, ni = lr * hi + li * hr + ui; hr = nr; hi = ni;
        }
        float* d = SLOC + ((size_t)((b * NCH + j) * NG + g) * NP + p) * 2; d[0] = hr; d[1] = hi;
    }
}
__device__ __forceinline__ void phase_ssm_out(const Args& a, LAS unsigned char* L, int lane, int wave, int gw, int NGW) {
    const bf16* QKVU = (const bf16*)(a.ws + WS_QKVU); const float* P = (const float*)(a.ws + WS_SSMP); const float* SLOC = (const float*)(a.ws + WS_SLOC); bf16* Gb = (bf16*)(a.ws + WS_G);
    LAS float* Cr = (LAS float*)(L + wave * 12800); LAS float* Ci = Cr + 16 * 65; LAS float* Hr = Ci + 16 * 65; LAS float* Hi = Hr + 8 * 64;
    const int NPI = NB * NCH * NG;
    for (int it = gw; it < NPI + 128 * NG; it += NGW) {
        const bool sample = it >= NPI; int g, j = 0, sq;
        if (!sample) { g = it & 31; j = (it >> 5) & (NCH - 1); sq = it >> 12; } else { const int r = it - NPI; g = r & 31; sq = r >> 5; }
        const int p = lane, gp = g * NP + p;
        const float lr = P[gp * 2], li = P[gp * 2 + 1], lTr = P[4096 + gp * 2], lTi = P[4096 + gp * 2 + 1];
        float br[NC], bi[NC];
#pragma unroll
        for (int c = 0; c < NC; ++c) { br[c] = P[8192 + (gp * NC + c) * 2]; bi[c] = P[8192 + (gp * NC + c) * 2 + 1]; }
        asm volatile("s_waitcnt lgkmcnt(0)" ::: "memory");
        for (int c = 0; c < NC; ++c) { Cr[c * 65 + p] = a.in[15][(g * NC + c) * NP + p]; Ci[c * 65 + p] = a.in[16][(g * NC + c) * NP + p]; }
        float hr = 0.f, hi = 0.f; size_t row0; int T;
        if (sample) { hr = a.in[4][(size_t)(sq * NG + g) * NP + p]; hi = a.in[5][(size_t)(sq * NG + g) * NP + p]; row0 = (size_t)MP + sq * 4; T = 4; }
        else { for (int i = 0; i < j; ++i) { const float* s = SLOC + ((size_t)((sq * NCH + i) * NG + g) * NP + p) * 2; const float nr = lTr * hr - lTi * hi + s[0], ni = lTr * hi + lTi * hr + s[1]; hr = nr; hi = ni; }
            row0 = (size_t)sq * SEQ + j * TCH; T = TCH; }
        const int yc = p & 15, yt = p >> 4; const float dv = a.in[17][g * NC + yc];
        for (int t0 = 0; t0 < T; t0 += 8) {
            const int nt = (T - t0) < 8 ? (T - t0) : 8;
            asm volatile("s_waitcnt lgkmcnt(0)" ::: "memory");
            for (int t = 0; t < nt; ++t) {
                const bf16* up = QKVU + (row0 + t0 + t) * NPROJ + 768 + g * NC;
                float ur = 0.f, ui = 0.f;
#pragma unroll
                for (int c = 0; c < NC; ++c) { const float u = bf2f(up[c]); ur += br[c] * u; ui += bi[c] * u; }
                const float nr = lr * hr - li * hi + ur, ni = lr * hi + li * hr + ui; hr = nr; hi = ni;
                Hr[t * 64 + p] = hr; Hi[t * 64 + p] = hi;
            }
            asm volatile("s_waitcnt lgkmcnt(0)" ::: "memory");
            for (int r = 0; r < 2; ++r) { const int t = r * 4 + yt; if (t < nt) {
                float y = 0.f;
                for (int pp = 0; pp < NP; ++pp) y += Hr[t * 64 + pp] * Cr[yc * 65 + pp] - Hi[t * 64 + pp] * Ci[yc * 65 + pp];
                const size_t row = row0 + t0 + t; y += dv * bf2f(QKVU[row * NPROJ + 768 + g * NC + yc]);
                Gb[row * 512 + g * NC + yc] = (bf16)f2bf(gelu_tanh(y)); } }
        }
        if (sample) { a.out[O_SRS + (size_t)(sq * NG + g) * NP + p] = hr; a.out[O_SIS + (size_t)(sq * NG + g) * NP + p] = hi; }
        else if (j == NCH - 1) { a.out[O_SRP + (size_t)(sq * NG + g) * NP + p] = hr; a.out[O_SIP + (size_t)(sq * NG + g) * NP + p] = hi; }
    }
}
__device__ __forceinline__ void phase_merge(const Args& a, int lane, int gw, int NGW) {
    const float* OATT = (const float*)(a.ws + WS_OATT); const float* OSSM = (const float*)(a.ws + WS_OSSM); bf16* MG = (bf16*)(a.ws + WS_MERGED);
    for (int row = gw; row < M; row += NGW) {
#pragma unroll
        for (int part = 0; part < 2; ++part) { const float* src = (part ? OSSM : OATT) + (size_t)row * 512; const float* gn = part ? a.in[21] : a.in[20];
            const f32x4 x = ((const f32x4*)src)[lane], y = ((const f32x4*)src)[64 + lane];
            const float ss = wave_sum((x.x * x.x + x.y * x.y) + (x.z * x.z + x.w * x.w) + (y.x * y.x + y.y * y.y) + (y.z * y.z + y.w * y.w));
            const float rstd = 1.f / sqrtf(ss * (1.f / 512.f) + 1e-6f);
            const f32x4 g0 = ((const f32x4*)gn)[lane], g1 = ((const f32x4*)gn)[64 + lane];
            unsigned long long* o8 = (unsigned long long*)(MG + (size_t)row * 1024 + part * 512);
            o8[lane] = (unsigned long long)pk2(x.x * rstd * g0.x, x.y * rstd * g0.y) | ((unsigned long long)pk2(x.z * rstd * g0.z, x.w * rstd * g0.w) << 32);
            o8[64 + lane] = (unsigned long long)pk2(y.x * rstd * g1.x, y.y * rstd * g1.y) | ((unsigned long long)pk2(y.z * rstd * g1.z, y.w * rstd * g1.w) << 32); }
    }
}
__device__ __forceinline__ void phase_rms_final(const Args& a, int lane, int gw, int NGW) {
    for (int row = gw; row < M; row += NGW) {
        f32x4* xr = (f32x4*)(a.out + (size_t)row * DM) + lane; const f32x4* gr = (const f32x4*)a.in[26] + lane;
        f32x4 v[4]; float s = 0.f;
#pragma unroll
        for (int j = 0; j < 4; ++j) { v[j] = xr[64 * j]; s += (v[j].x * v[j].x + v[j].y * v[j].y) + (v[j].z * v[j].z + v[j].w * v[j].w); }
        const float rstd = 1.f / sqrtf(wave_sum(s) * (1.f / 1024.f) + 1e-6f);
#pragma unroll
        for (int j = 0; j < 4; ++j) xr[64 * j] = v[j] * rstd * gr[64 * j];
    }
}

__global__ void __launch_bounds__(512, 2) mk_fwd(Args a) {
    extern __shared__ __attribute__((aligned(16))) unsigned char lds[];
    LAS unsigned char* L = (LAS unsigned char*)lds;
    const int tid = threadIdx.x, lane = tid & 63, wave = __builtin_amdgcn_readfirstlane(tid >> 6);
    const int G = gridDim.x, bx = blockIdx.x, gw = bx * 8 + wave, NGW = G * 8;
    for (int u = tid; u < (LDS_BYTES - LDSCTL_OFF) / 4; u += 512) ((LAS unsigned*)(L + LDSCTL_OFF))[u] = 0u;
    __syncthreads();
    unsigned* ctl = (unsigned*)(a.ws + WS_CTL);
    XcdBarrier bar = xcd_barrier_post(ctl + CW_BAR, (volatile LAS unsigned*)(L + MISC_OFF) + 8);
    unsigned char* ws = a.ws;
    bf16 *XN = (bf16*)(ws + WS_XN), *QKVU = (bf16*)(ws + WS_QKVU), *MG = (bf16*)(ws + WS_MERGED), *H = (bf16*)(ws + WS_H), *Gb = (bf16*)(ws + WS_G);
    float* OSSM = (float*)(ws + WS_OSSM);
    PG8_LAS unsigned char* RL = (PG8_LAS unsigned char*)lds;

    phase_prologue(a, L, tid, lane, wave, bx, G);
    xcd_barrier(bar);
    { pg8::Gemm g{XN, (const bf16*)(ws + WS_WIN), M, NPROJ, DM}; pg8::StaticOrder S; S.init(M, NPROJ, G, bx);
      pg8::gemm_phase<pg8::EpiInProj, pg8::StaticOrder, true, true>(RL, g, S, pg8::EpiInProj{QKVU, a.out, NPROJ, 0}); }
    xcd_barrier(bar);
    phase_attn_prompt_simple(a, L, tid, bx, G);
    phase_attn_sample(a, lane, gw, NGW);
    phase_ssm_local(a, lane, gw, NGW);
    xcd_barrier(bar);
    phase_ssm_out(a, L, lane, wave, gw, NGW);
    xcd_barrier(bar);
    { pg8::Gemm g{Gb, (const bf16*)(ws + WS_WGLU), M, 512, 512}; pg8::StaticOrder S; S.init(M, 512, G, bx);
      pg8::gemm_phase<pg8::EpiGlu, pg8::StaticOrder, true, true>(RL, g, S, pg8::EpiGlu{Gb, a.in[19], OSSM, 512, 0}); }
    xcd_barrier(bar);
    phase_merge(a, lane, gw, NGW);
    xcd_barrier(bar);
    { pg8::Gemm g{MG, (const bf16*)(ws + WS_WOUT), M, DM, DM}; pg8::StaticOrder S; S.init(M, DM, G, bx);
      pg8::gemm_phase<pg8::EpiF32Res, pg8::StaticOrder, true, true>(RL, g, S, pg8::EpiF32Res{a.in[0], a.in[1], a.out, DM, 0}); }
    xcd_barrier(bar);
    for (int m = gw; m < M; m += NGW) rms_row_to_bf16(a.out + (size_t)m * DM, a.in[23], XN + (size_t)m * DM, lane);
    xcd_barrier(bar);
    { pg8::Gemm g{XN, (const bf16*)(ws + WS_WUP), M, FF, DM}; pg8::StaticOrder S; S.init(M, FF, G, bx);
      pg8::gemm_phase<pg8::EpiRelu2, pg8::StaticOrder, true, true>(RL, g, S, pg8::EpiRelu2{H, FF, 0}); }
    xcd_barrier(bar);
    { pg8::Gemm g{H, (const bf16*)(ws + WS_WDN), M, DM, FF}; pg8::StaticOrder S; S.init(M, DM, G, bx);
      pg8::gemm_phase<pg8::EpiF32Res, pg8::StaticOrder, true, true>(RL, g, S, pg8::EpiF32Res{a.out, a.out + (size_t)MP * DM, a.out, DM, 0}); }
    xcd_barrier(bar);
    phase_rms_final(a, lane, gw, NGW);
}

extern "C" void kernel_launch(void* const* d_in, const int* in_sizes, int n_in, void* d_out, int out_size, void* d_ws, size_t ws_size, hipStream_t stream) {
    static int grid = 0;
    if (grid == 0) {
        if (n_in != 27 || out_size != 22093824 || ws_size < WS_END) { fprintf(stderr, "kernel_launch: unexpected sizes n_in %d out %d ws %zu\n", n_in, out_size, ws_size); grid = -1; return; }
        int dev = 0, cus = 0, per_cu = 0;
        if (hipGetDevice(&dev) != hipSuccess || hipDeviceGetAttribute(&cus, hipDeviceAttributeMultiprocessorCount, dev) != hipSuccess) { grid = -1; return; }
        if (hipFuncSetAttribute((const void*)mk_fwd, hipFuncAttributeMaxDynamicSharedMemorySize, LDS_BYTES) != hipSuccess) { fprintf(stderr, "kernel_launch: hipFuncSetAttribute failed\n"); grid = -1; return; }
        if (hipOccupancyMaxActiveBlocksPerMultiprocessor(&per_cu, (const void*)mk_fwd, 512, LDS_BYTES) != hipSuccess || per_cu < 1) fprintf(stderr, "kernel_launch: occupancy query reports %d\n", per_cu);
        (void)hipGetLastError();
        grid = cus;
    }
    if (grid < 0) return;
    if (hipMemsetAsync((char*)d_ws + WS_CTL, 0, CTL_ZERO_BYTES, stream) != hipSuccess) return;
    Args a{};
    for (int i = 0; i < 27; ++i) a.in[i] = (const float*)d_in[i];
    a.out = (float*)d_out; a.ws = (unsigned char*)d_ws;
    hipLaunchKernelGGL(mk_fwd, dim3(grid), dim3(512), LDS_BYTES, stream, a);
}
```

```cpp
#include <hip/hip_runtime.h>
#include <cstdio>
#include <cstdint>
namespace pg8 {
#define PG8_LAS __attribute__((address_space(3)))
typedef unsigned short bf16_t;
typedef short bf16x8 __attribute__((ext_vector_type(8)));
typedef float f32x4 __attribute__((ext_vector_type(4)));
typedef unsigned u32x4 __attribute__((ext_vector_type(4)));
constexpr int BM = 256, BK = 64, HALF = 128, HTB = HALF * BK * 2  , STAGE_BYTES = 8 * HTB, NXCD = 8, WGM = 8;

__host__ __device__ __forceinline__ int lds_byte(int r, int c) { const int st = (r >> 4) * 2 + (c >> 5), rr = r & 15, cc = c & 31, ob = rr * 64 + cc * 2; return st * 1024 + (ob ^ (((ob >> 9) & 1) << 5)); }
__host__ __device__ __forceinline__ void stage_rc(int b, int& R, int& C) { const int st = b / 1024, sb = b % 1024, swz = sb ^ (((sb >> 9) & 1) << 5); R = (st >> 1) * 16 + swz / 64; C = (st & 1) * 32 + (swz % 64) / 2; }
__host__ __device__ __forceinline__ int perm32(int rho) { const int n = rho >> 4, i = rho & 15; return 8 * (i >> 2) + 4 * n + (i & 3); }

struct Unit { int pm, pn; };
struct Gemm { const bf16_t* A; const bf16_t* Bt; int M, N, K; };

struct StaticOrder {
    int nM, nN, nwg, G, c;
    __host__ __device__ void init(int M, int N, int G_, int c_) { nM = M / BM; nN = N / BM; nwg = nM * nN; G = G_; c = c_; }
    __host__ __device__ bool next(int i, Unit& u) const {
        const long L = (long)i * G + c; if (L >= nwg) return false;
        int wgid = (int)L; { const int q = nwg / NXCD, r = nwg % NXCD, xcd = wgid % NXCD, off = wgid / NXCD; wgid = (xcd < r ? xcd * (q + 1) : r * (q + 1) + (xcd - r) * q) + off; }
        const int nig = WGM * nN, gid = wgid / nig, fm = gid * WGM, gsz = (nM - fm) < WGM ? (nM - fm) : WGM;
        u.pm = fm + ((wgid % nig) % gsz); u.pn = (wgid % nig) / gsz; return true;
    }
    __device__ __forceinline__ void a_ready(const Unit&) const {}
    __device__ __forceinline__ void done(const Unit&) const {}
};


__device__ __forceinline__ unsigned cvt_pk_bf16(float lo, float hi) { unsigned r; asm volatile("v_cvt_pk_bf16_f32 %0, %1, %2" : "=v"(r) : "v"(lo), "v"(hi)); return r; }

struct EpiInProj {
    static constexpr bool PERM = true, AFTER_DRAIN = false;
    bf16_t* O; float* out; int ldc; int pad;
    __device__ __forceinline__ void operator()(const f32x4 (&acc)[2][2][4][2], const Unit& u, int wr, int wc, int fr, int fq) const {
        const int row0 = u.pm * BM + wr * 64 + fr; const int col0 = u.pn * BM + wc * 32 + 8 * fq;
#pragma unroll
        for (int ai = 0; ai < 2; ++ai)
#pragma unroll
            for (int m = 0; m < 4; ++m) { const int row = row0 + ai * HALF + m * 16; bf16_t* rowp = O + (size_t)row * ldc + col0;
#pragma unroll
                for (int bj = 0; bj < 2; ++bj) { const f32x4 v0 = acc[ai][bj][m][0], v1 = acc[ai][bj][m][1];
                    u32x4 w; w.x = cvt_pk_bf16(v0[0], v0[1]); w.y = cvt_pk_bf16(v0[2], v0[3]); w.z = cvt_pk_bf16(v1[0], v1[1]); w.w = cvt_pk_bf16(v1[2], v1[3]);
                    *(u32x4*)(rowp + bj * HALF) = w; }
                if (u.pn == 2) {
                    long dst = -1;
                    if (row < 16384) { const int t = row & 8191, b = row >> 13; if (t >= 8192 - 128) dst = (long)(b * 128 + (t - (8192 - 128))) * 128; }
                    else { const int si = row - 16384; dst = (long)((si >> 2) * 128 + 124 + (si & 3)) * 128; }
                    if (dst >= 0) { const int kc = wc * 32 + 8 * fq;
                        float* kd = out + (row < 16384 ? 17301504L : 17375232L) + dst + kc;
                        float* vd = out + (row < 16384 ? 17334272L : 19472384L) + dst + kc;
                        *(f32x4*)(kd) = acc[ai][0][m][0]; *(f32x4*)(kd + 4) = acc[ai][0][m][1];
                        *(f32x4*)(vd) = acc[ai][1][m][0]; *(f32x4*)(vd + 4) = acc[ai][1][m][1]; }
                }
            }
    }
};
struct EpiF32Res {
    static constexpr bool PERM = false, AFTER_DRAIN = false;
    const float* b0; const float* b1; float* O; int ldc; int pad;
    __device__ __forceinline__ void operator()(const f32x4 (&acc)[2][2][4][2], const Unit& u, int wr, int wc, int fr, int fq) const {
        const int row0 = u.pm * BM + wr * 64 + fr; const int col0 = u.pn * BM + wc * 32 + 4 * fq;
#pragma unroll
        for (int ai = 0; ai < 2; ++ai)
#pragma unroll
            for (int m = 0; m < 4; ++m) { const int row = row0 + ai * HALF + m * 16;
                const float* bp = (row < 16384 ? b0 + (size_t)row * ldc : b1 + (size_t)(row - 16384) * ldc) + col0; float* op = O + (size_t)row * ldc + col0;
#pragma unroll
                for (int bj = 0; bj < 2; ++bj)
#pragma unroll
                    for (int n = 0; n < 2; ++n) { const f32x4 bs = *(const f32x4*)(bp + bj * HALF + n * 16); *(f32x4*)(op + bj * HALF + n * 16) = bs + acc[ai][bj][m][n]; }
            }
    }
};
struct EpiRelu2 {
    static constexpr bool PERM = true, AFTER_DRAIN = false;
    bf16_t* O; int ldc; int pad;
    __device__ __forceinline__ void operator()(const f32x4 (&acc)[2][2][4][2], const Unit& u, int wr, int wc, int fr, int fq) const {
        const int row0 = u.pm * BM + wr * 64 + fr; const int col0 = u.pn * BM + wc * 32 + 8 * fq;
#pragma unroll
        for (int ai = 0; ai < 2; ++ai)
#pragma unroll
            for (int m = 0; m < 4; ++m) { bf16_t* rowp = O + (size_t)(row0 + ai * HALF + m * 16) * ldc + col0;
#pragma unroll
                for (int bj = 0; bj < 2; ++bj) { f32x4 v0 = acc[ai][bj][m][0], v1 = acc[ai][bj][m][1];
#pragma unroll
                    for (int j = 0; j < 4; ++j) { const float a = fmaxf(v0[j], 0.f), b = fmaxf(v1[j], 0.f); v0[j] = a * a; v1[j] = b * b; }
                    u32x4 w; w.x = cvt_pk_bf16(v0[0], v0[1]); w.y = cvt_pk_bf16(v0[2], v0[3]); w.z = cvt_pk_bf16(v1[0], v1[1]); w.w = cvt_pk_bf16(v1[2], v1[3]);
                    *(u32x4*)(rowp + bj * HALF) = w; } }
    }
};
__device__ __forceinline__ float bf2f(bf16_t b) { return __uint_as_float((unsigned)b << 16); }
struct EpiGlu {
    static constexpr bool PERM = false, AFTER_DRAIN = false;
    const bf16_t* G; const float* bias; float* O; int ldc; int pad;
    __device__ __forceinline__ void operator()(const f32x4 (&acc)[2][2][4][2], const Unit& u, int wr, int wc, int fr, int fq) const {
        const int row0 = u.pm * BM + wr * 64 + fr; const int col0 = u.pn * BM + wc * 32 + 4 * fq;
#pragma unroll
        for (int ai = 0; ai < 2; ++ai)
#pragma unroll
            for (int m = 0; m < 4; ++m) { const size_t ro = (size_t)(row0 + ai * HALF + m * 16) * ldc + col0;
#pragma unroll
                for (int bj = 0; bj < 2; ++bj)
#pragma unroll
                    for (int n = 0; n < 2; ++n) { const int co = bj * HALF + n * 16; const f32x4 bv = *(const f32x4*)(bias + col0 + co);
                        const unsigned long long gw = *(const unsigned long long*)(G + ro + co); f32x4 o;
#pragma unroll
                        for (int j = 0; j < 4; ++j) { const float g = bf2f((bf16_t)(gw >> (16 * j))); const float z = acc[ai][bj][m][n][j] + bv[j]; o[j] = g / (1.f + __expf(-z)); }
                        *(f32x4*)(O + ro + co) = o; }
            }
    }
};
template <class Epi, class Sched, bool ALIGN_EPI = false, bool SP2 = false>
__device__ __forceinline__ void gemm_phase(PG8_LAS unsigned char* lds, const Gemm g, const Sched& S, const Epi& E) {
    const int tid = threadIdx.x, wid = __builtin_amdgcn_readfirstlane(tid >> 6), lane = tid & 63, wr = wid >> 2, wc = wid & 3, fr = lane & 15, fq = lane >> 4;
    const int K = g.K, nt = K / BK;
    unsigned voffA[2], voffB[2];
#pragma unroll
    for (int i = 0; i < 2; ++i) { int R, C; stage_rc(tid * 16 + i * 8192, R, C); const int Rb = Epi::PERM ? ((R & ~31) + perm32(R & 31)) : R;
        voffA[i] = (unsigned)(R * K + C) * 2u; voffB[i] = (unsigned)(Rb * K + C) * 2u; }
    const size_t kstep = (size_t)(BK * 2);
    const size_t hstep = (size_t)HALF * K * 2;
    const size_t tstep = 2 * hstep;
    const unsigned ldsw = (unsigned)wid * 1024u;
    const int aoff = lds_byte(wr * 64 + fr, fq * 8), boff = lds_byte(wc * 32 + fr, fq * 8);
#define PG8_SA(b, h) (((b) * 2 + (h)) * HTB)
#define PG8_SB(b, h) ((4 + (b) * 2 + (h)) * HTB)
#define PG8_STAGE(bufoff, gbase, voff) do { _Pragma("unroll") for (int _i = 0; _i < 2; ++_i) \
        __builtin_amdgcn_global_load_lds((const unsigned*)((const char*)(gbase) + (voff)[_i]), (PG8_LAS unsigned*)(lds + (bufoff) + ldsw + _i * 8192), 16, 0, 0); } while (0)
#define PG8_LDA(dst, b, h) do { _Pragma("unroll") for (int m = 0; m < 4; ++m) _Pragma("unroll") for (int k = 0; k < 2; ++k) dst[m][k] = *(const PG8_LAS bf16x8*)(lds + PG8_SA(b, h) + aoff + m * 2048 + k * 1024); } while (0)
#define PG8_LDB(dst, b, h) do { _Pragma("unroll") for (int n = 0; n < 2; ++n) _Pragma("unroll") for (int k = 0; k < 2; ++k) dst[n][k] = *(const PG8_LAS bf16x8*)(lds + PG8_SB(b, h) + boff + n * 2048 + k * 1024); } while (0)
#define PG8_MMA(ai, bj, At, Bt) do { __builtin_amdgcn_s_setprio(1); _Pragma("unroll") for (int m = 0; m < 4; ++m) _Pragma("unroll") for (int n = 0; n < 2; ++n) _Pragma("unroll") for (int k = 0; k < 2; ++k) \
        acc[ai][bj][m][n] = __builtin_amdgcn_mfma_f32_16x16x32_bf16(Bt[n][k], At[m][k], acc[ai][bj][m][n], 0, 0, 0); __builtin_amdgcn_s_setprio(0); } while (0)
#define PG8_WAIT_V(n) asm volatile("s_waitcnt vmcnt(" #n ")" ::: "memory")
#define PG8_WAIT_L(n) asm volatile("s_waitcnt lgkmcnt(" #n ")" ::: "memory")
#define PG8_BAR __builtin_amdgcn_s_barrier()
#define PG8_SCHED __builtin_amdgcn_sched_barrier(0)
    Unit cur, nxt; int ui = 0;
    if (!S.next(0, cur)) return;
    f32x4 acc[2][2][4][2];
#pragma unroll
    for (int a = 0; a < 2; ++a)
#pragma unroll
        for (int b = 0; b < 2; ++b)
#pragma unroll
            for (int m = 0; m < 4; ++m)
#pragma unroll
                for (int n = 0; n < 2; ++n) acc[a][b][m][n] = (f32x4){0.f, 0.f, 0.f, 0.f};
    bf16x8 At[4][2], B0[2][2], B1[2][2];
    const char* cA = (const char*)g.A + (size_t)cur.pm * tstep; const char* cB = (const char*)g.Bt + (size_t)cur.pn * tstep;
    S.a_ready(cur);
    if constexpr (SP2) {
        PG8_STAGE(PG8_SB(0, 0), cB, voffB); PG8_STAGE(PG8_SB(0, 1), cB + hstep, voffB); PG8_STAGE(PG8_SA(0, 0), cA, voffA); PG8_STAGE(PG8_SA(0, 1), cA + hstep, voffA);
        if (wr == 1) PG8_BAR;
        PG8_WAIT_V(2); PG8_BAR;
        PG8_STAGE(PG8_SB(1, 0), cB + kstep, voffB); PG8_STAGE(PG8_SA(1, 0), cA + kstep, voffA); PG8_STAGE(PG8_SB(1, 1), cB + hstep + kstep, voffB);
        PG8_WAIT_V(6); PG8_BAR;
    } else {
        PG8_STAGE(PG8_SB(0, 0), cB, voffB); PG8_STAGE(PG8_SA(0, 0), cA, voffA); PG8_STAGE(PG8_SB(0, 1), cB + hstep, voffB); PG8_STAGE(PG8_SA(0, 1), cA + hstep, voffA);
        if (wr == 1) PG8_BAR;
        PG8_WAIT_V(4); PG8_BAR;
        PG8_STAGE(PG8_SB(1, 0), cB + kstep, voffB); PG8_STAGE(PG8_SA(1, 0), cA + kstep, voffA); PG8_STAGE(PG8_SB(1, 1), cB + hstep + kstep, voffB);
        PG8_WAIT_V(6); PG8_BAR;
    }
    for (;;) {
        const bool has_next = S.next(ui + 1, nxt);
        const char* nA = has_next ? (const char*)g.A + (size_t)nxt.pm * tstep : cA; const char* nB = has_next ? (const char*)g.Bt + (size_t)nxt.pn * tstep : cB;
        for (int t = 0; t < nt; t += 2) {
            const bool last = (t == nt - 2);
            const char* a1 = cA + (size_t)(t + 1) * kstep;
            const char* a2 = last ? nA : cA + (size_t)(t + 2) * kstep; const char* b2 = last ? nB : cB + (size_t)(t + 2) * kstep;
            const char* a3 = a2 + kstep; const char* b3 = b2 + kstep;
            if (last && has_next) S.a_ready(nxt);
            if constexpr (SP2) {
            PG8_LDB(B0, 0, 0); PG8_LDB(B1, 0, 1); PG8_SCHED; PG8_LDA(At, 0, 0); PG8_STAGE(PG8_SA(1, 1), a1 + hstep, voffA);
            PG8_WAIT_V(8); PG8_WAIT_L(0); PG8_BAR; PG8_MMA(0, 0, At, B0); PG8_MMA(0, 1, At, B1); PG8_BAR; PG8_SCHED;
            PG8_LDA(At, 0, 1); PG8_STAGE(PG8_SB(0, 0), b2, voffB); PG8_STAGE(PG8_SB(0, 1), b2 + hstep, voffB); PG8_STAGE(PG8_SA(0, 0), a2, voffA);
            PG8_WAIT_V(8); PG8_WAIT_L(0); PG8_BAR; PG8_MMA(1, 0, At, B0); PG8_MMA(1, 1, At, B1); PG8_BAR; PG8_SCHED;
            PG8_LDB(B0, 1, 0); PG8_LDB(B1, 1, 1); PG8_SCHED; PG8_LDA(At, 1, 0); PG8_STAGE(PG8_SA(0, 1), a2 + hstep, voffA);
            PG8_WAIT_V(8); PG8_WAIT_L(0); PG8_BAR; PG8_MMA(0, 0, At, B0); PG8_MMA(0, 1, At, B1); PG8_BAR; PG8_SCHED;
            PG8_LDA(At, 1, 1); PG8_STAGE(PG8_SB(1, 0), b3, voffB); PG8_STAGE(PG8_SB(1, 1), b3 + hstep, voffB); PG8_STAGE(PG8_SA(1, 0), a3, voffA);
            PG8_WAIT_V(8); PG8_WAIT_L(0); PG8_BAR; PG8_MMA(1, 0, At, B0); PG8_MMA(1, 1, At, B1); PG8_BAR; PG8_SCHED;
            } else {
            PG8_LDB(B0, 0, 0); PG8_SCHED; PG8_LDA(At, 0, 0); PG8_STAGE(PG8_SA(1, 1), a1 + hstep, voffA);
            PG8_WAIT_L(8); PG8_BAR; PG8_WAIT_L(0); PG8_MMA(0, 0, At, B0); PG8_BAR; PG8_SCHED;
            PG8_LDB(B1, 0, 1); PG8_STAGE(PG8_SB(0, 0), b2, voffB);
            PG8_BAR; PG8_WAIT_L(0); PG8_MMA(0, 1, At, B1); PG8_BAR;
            PG8_LDA(At, 0, 1); PG8_STAGE(PG8_SA(0, 0), a2, voffA);
            PG8_BAR; PG8_WAIT_L(0); PG8_MMA(1, 0, At, B0); PG8_BAR; PG8_SCHED;
            PG8_STAGE(PG8_SB(0, 1), b2 + hstep, voffB);
            PG8_WAIT_V(6); PG8_BAR; PG8_MMA(1, 1, At, B1); PG8_BAR;
            PG8_LDB(B0, 1, 0); PG8_SCHED; PG8_LDA(At, 1, 0); PG8_STAGE(PG8_SA(0, 1), a2 + hstep, voffA);
            PG8_WAIT_L(8); PG8_BAR; PG8_WAIT_L(0); PG8_MMA(0, 0, At, B0); PG8_BAR; PG8_SCHED;
            PG8_LDB(B1, 1, 1); PG8_STAGE(PG8_SB(1, 0), b3, voffB);
            PG8_BAR; PG8_WAIT_L(0); PG8_MMA(0, 1, At, B1); PG8_BAR;
            PG8_LDA(At, 1, 1); PG8_STAGE(PG8_SA(1, 0), a3, voffA);
            PG8_BAR; PG8_WAIT_L(0); PG8_MMA(1, 0, At, B0); PG8_BAR; PG8_SCHED;
            PG8_STAGE(PG8_SB(1, 1), b3 + hstep, voffB);
            PG8_WAIT_V(6); PG8_BAR; PG8_MMA(1, 1, At, B1); PG8_BAR;
            }
        }
        if constexpr (ALIGN_EPI) { if (wr == 0) PG8_BAR; }
        if constexpr (!Epi::AFTER_DRAIN) { E(acc, cur, wr, wc, fr, fq); S.done(cur); }
        if (!has_next) break;
#pragma unroll
        for (int a = 0; a < 2; ++a)
#pragma unroll
            for (int b = 0; b < 2; ++b)
#pragma unroll
                for (int m = 0; m < 4; ++m)
#pragma unroll
                    for (int n = 0; n < 2; ++n) acc[a][b][m][n] = (f32x4){0.f, 0.f, 0.f, 0.f};
        cur = nxt; cA = nA; cB = nB; ++ui;
        if constexpr (ALIGN_EPI) { if (wr == 1) PG8_BAR; }
    }
    PG8_WAIT_V(0);
    if constexpr (!ALIGN_EPI) { if (wr == 0) PG8_BAR; }
    PG8_BAR;
    if constexpr (Epi::AFTER_DRAIN) { E.fused(acc, cur, wr, wc, fr, fq, lds, wid, lane); S.done(cur); }
#undef PG8_SA
#undef PG8_SB
#undef PG8_STAGE
#undef PG8_LDA
#undef PG8_LDB
#undef PG8_MMA
#undef PG8_WAIT_V
#undef PG8_WAIT_L
#undef PG8_BAR
#undef PG8_SCHED
}
}

constexpr int DM = 1024, SEQ = 8192, NB = 2, MP = NB * SEQ, MS = 512, M = MP + MS;
constexpr int NPROJ = 1280, FF = 4096, NG = 32, NP = 64, NC = 16;
constexpr long O_YP = 0, O_YS = 16777216, O_KP = 17301504, O_VP = 17334272, O_SRP = 17367040, O_SIP = 17371136, O_KS = 17375232, O_VS = 19472384, O_SRS = 21569536, O_SIS = 21831680;
constexpr int TCH = 64, NCH = SEQ / TCH;
typedef unsigned short bf16;
typedef float f32x4 __attribute__((ext_vector_type(4)));
typedef unsigned v4u __attribute__((ext_vector_type(4)));
#define LAS __attribute__((address_space(3)))
#define GAS __attribute__((address_space(1)))

constexpr size_t MiB = 1u << 20;
constexpr size_t WS_CTL = 0;
constexpr size_t WS_WIN = 1 * MiB;
constexpr size_t WS_WOUT = 4 * MiB;
constexpr size_t WS_WUP = 6 * MiB;
constexpr size_t WS_WDN = 14 * MiB;
constexpr size_t WS_WGLU = 22 * MiB;
constexpr size_t WS_SSMP = 23 * MiB;
constexpr size_t WS_XN = 24 * MiB;
constexpr size_t WS_QKVU = 58 * MiB;
constexpr size_t WS_MERGED = 100 * MiB;
constexpr size_t WS_H = 58 * MiB;
constexpr size_t WS_OATT = 134 * MiB;
constexpr size_t WS_OSSM = 168 * MiB;
constexpr size_t WS_G = 202 * MiB;
constexpr size_t WS_SLOC = 220 * MiB;
constexpr size_t WS_END = 256 * MiB;

__device__ __forceinline__ unsigned f2bf(float f) { unsigned u = __builtin_bit_cast(unsigned, f); return (u + 0x7fffu + ((u >> 16) & 1u)) >> 16; }
__device__ __forceinline__ unsigned pk2(float lo, float hi) { return f2bf(lo) | (f2bf(hi) << 16); }
__device__ __forceinline__ float bf2f(bf16 b) { return __uint_as_float((unsigned)b << 16); }
__device__ __forceinline__ float wave_sum(float v) {
#pragma unroll
    for (int o = 1; o < 64; o <<= 1) v += __shfl_xor(v, o);
    return v;
}

__device__ __forceinline__ void p0_transpose_item(const float* W, int K, int N, bf16* WT, LAS float* scr, int item, int lane) {
    const int nblk = N / 32, kb = item / nblk, nb = item % nblk, k0 = 64 * kb, n0 = 32 * nb;
#pragma unroll 8
    for (int i = 0; i < 32; ++i) { const int kk = 2 * i + (lane >> 5); scr[kk * 33 + (lane & 31)] = W[(size_t)(k0 + kk) * N + n0 + (lane & 31)]; }
    asm volatile("s_waitcnt lgkmcnt(0)" ::: "memory");
    const int c = lane & 7;
#pragma unroll
    for (int j = 0; j < 4; ++j) { const int n = (lane >> 3) + 8 * j; const LAS float* s = scr + (8 * c) * 33 + n;
        v4u o; o.x = pk2(s[0 * 33], s[1 * 33]); o.y = pk2(s[2 * 33], s[3 * 33]); o.z = pk2(s[4 * 33], s[5 * 33]); o.w = pk2(s[6 * 33], s[7 * 33]);
        *(v4u*)(WT + (size_t)(n0 + n) * K + k0 + 8 * c) = o; }
    asm volatile("s_waitcnt lgkmcnt(0)" ::: "memory");
}
__device__ __forceinline__ void rms_row_to_bf16(const float* xrow, const float* gain, bf16* orow, int lane) {
    const f32x4* xr = (const f32x4*)xrow + lane; const f32x4* gr = (const f32x4*)gain + lane;
    f32x4 v[4]; float s = 0.f;
#pragma unroll
    for (int j = 0; j < 4; ++j) { v[j] = xr[64 * j]; s += (v[j].x * v[j].x + v[j].y * v[j].y) + (v[j].z * v[j].z + v[j].w * v[j].w); }
    const float rstd = 1.f / sqrtf(wave_sum(s) * (1.f / 1024.f) + 1e-6f);
    unsigned long long* o8 = (unsigned long long*)orow + lane;
#pragma unroll
    for (int j = 0; j < 4; ++j) { const f32x4 g = gr[64 * j]; o8[64 * j] = (unsigned long long)pk2(v[j].x * rstd * g.x, v[j].y * rstd * g.y) | ((unsigned long long)pk2(v[j].z * rstd * g.z, v[j].w * rstd * g.w) << 32); }
}

#define XB_TMO      128
#define XB_XCNT(j)  (256  + 64 * (j))
#define XB_XSUB(j)  (1280 + 64 * (j))
#define XB_XGEN(j)  (2304 + 64 * (j))
#define XB_TOP      3328
#define XB_TOPGEN   3392
#define XCD_BAR_WORDS 3456
#define XB_SPIN_CAP (1u << 18)

__device__ __forceinline__ unsigned xb_ld(unsigned* p)              { return __hip_atomic_load(p, __ATOMIC_RELAXED, __HIP_MEMORY_SCOPE_AGENT); }
__device__ __forceinline__ unsigned xb_add(unsigned* p, unsigned v) { return __hip_atomic_fetch_add(p, v, __ATOMIC_RELAXED, __HIP_MEMORY_SCOPE_AGENT); }
__device__ __forceinline__ unsigned xb_xcc_id() { return (unsigned)__builtin_amdgcn_s_getreg((3 << 11) | 20) & 0xFu; }
#define XB_SPIN(cond, bar) do { unsigned _sp = 0; while (cond) { __builtin_amdgcn_s_sleep(1); \
    if ((++_sp & 255u) == 0u) { if (xb_ld(&(bar)[XB_TMO])) break; if (_sp > XB_SPIN_CAP) { atomicAdd(&(bar)[XB_TMO], 1u); break; } } } } while (0)

struct XcdBarrier {
    unsigned* bar; unsigned x;
    volatile LAS unsigned* st;
};

__device__ __forceinline__ XcdBarrier xcd_barrier_post(unsigned* bar, volatile LAS unsigned* st) {
    XcdBarrier b; b.bar = bar; b.x = xb_xcc_id(); b.st = st;
    if (threadIdx.x == 0) (void)xb_add(&bar[XB_XCNT(b.x)], 1u);
    return b;
}
__device__ __forceinline__ void xcd_barrier_complete(unsigned* bar, unsigned x, unsigned& nloc, unsigned& nx) {
    const unsigned G = gridDim.x * gridDim.y * gridDim.z;
    unsigned sum, cnt, mine, sp = 0u;
    for (;;) {
        sum = 0u; cnt = 0u; mine = 0u;
#pragma unroll
        for (unsigned j = 0; j < 16; ++j) { const unsigned c = xb_ld(&bar[XB_XCNT(j)]); sum += c; cnt += (c > 0u) ? 1u : 0u; mine = (j == x) ? c : mine; }
        if (sum == G) break;
        __builtin_amdgcn_s_sleep(1);
        if ((++sp & 255u) == 0u) { if (xb_ld(&bar[XB_TMO])) break; if (sp > XB_SPIN_CAP) { atomicAdd(&bar[XB_TMO], 1u); break; } }
    }
    nloc = mine > 0u ? mine : 1u; nx = cnt > 0u ? cnt : 1u;
}

__device__ __forceinline__ void xcd_barrier(const XcdBarrier& b) {
    asm volatile("s_waitcnt vmcnt(0)" ::: "memory");
    __syncthreads();
    if (threadIdx.x == 0) {
        unsigned* bar = b.bar;
        __builtin_amdgcn_s_waitcnt(0);
        unsigned nloc = b.st[0], nx = b.st[1];
        if (nloc == 0u) { xcd_barrier_complete(bar, b.x, nloc, nx); b.st[0] = nloc; b.st[1] = nx; }
        const unsigned old = xb_add(&bar[XB_XSUB(b.x)], 1u);
        const unsigned gen = old / nloc;
        if (old + 1u == (gen + 1u) * nloc) {
            __builtin_amdgcn_fence(__ATOMIC_RELEASE, "agent");
            asm volatile("s_waitcnt vmcnt(0)" ::: "memory");
            const unsigned og = xb_add(&bar[XB_TOP], 1u);
            const unsigned tg = og / nx;
            if (og + 1u == (tg + 1u) * nx) xb_add(&bar[XB_TOPGEN], 1u);
            else XB_SPIN(xb_ld(&bar[XB_TOPGEN]) == tg, bar);
            __builtin_amdgcn_fence(__ATOMIC_ACQUIRE, "agent");
            xb_add(&bar[XB_XGEN(b.x)], 1u);
            asm volatile("s_waitcnt vmcnt(0)" ::: "memory");
        } else {
            XB_SPIN(xb_ld(&bar[XB_XGEN(b.x)]) == gen, bar);
            __builtin_amdgcn_fence(__ATOMIC_ACQUIRE, "agent");
            asm volatile("s_waitcnt vmcnt(0)" ::: "memory");
        }
    }
    __syncthreads();
}

typedef GAS unsigned gu32;
constexpr int CW_BAR = 4096;
constexpr size_t CTL_ZERO_BYTES = 64 * 1024;
constexpr int RING_BYTES = 131072, LDSCTL_OFF = RING_BYTES, MISC_OFF = LDSCTL_OFF + 320, LDS_BYTES = 147456;
struct Args { const float* in[27]; float* out; unsigned char* ws; };

__device__ __forceinline__ int rel_bucket(int n) {
    if (n < 16) return n;
    const int l = 16 + (int)(logf((float)n / 16.f) / logf(8.f) * 16.f);
    return l < 31 ? l : 31;
}
__device__ __forceinline__ float gelu_tanh(float x) { const float u = 0.7978845608028654f * (x + 0.044715f * x * x * x); return 0.5f * x * (1.f + tanhf(u)); }


typedef short bf16x8 __attribute__((ext_vector_type(8)));
typedef float f32x16 __attribute__((ext_vector_type(16)));
typedef unsigned u32x2 __attribute__((ext_vector_type(2)));
constexpr size_t SSM_LB = WS_SSMP;
constexpr size_t SSM_BBT = WS_SSMP + 128 * 1024;
constexpr size_t SSM_CCT = WS_SSMP + 256 * 1024;
constexpr size_t WS_PRE = WS_SLOC;
constexpr size_t WS_TOT = WS_SLOC + 4 * MiB;
__device__ __forceinline__ unsigned cvtpk(float lo, float hi) { unsigned r; asm volatile("v_cvt_pk_bf16_f32 %0, %1, %2" : "=v"(r) : "v"(lo), "v"(hi)); return r; }
struct cplx { float r, i; };
__device__ __forceinline__ cplx cmul(cplx a, cplx b) { return {a.r * b.r - a.i * b.i, a.r * b.i + a.i * b.r}; }
__device__ __forceinline__ cplx cfma(cplx l, cplx h, cplx u) { return {l.r * h.r - l.i * h.i + u.r, l.r * h.i + l.i * h.r + u.i}; }
__device__ __forceinline__ cplx ldc(const float* p) { const float2 v = *(const float2*)p; return {v.x, v.y}; }
__device__ __forceinline__ int tok_of_row(int rho) { return 16 * ((rho >> 2) & 1) + (rho & 3) + 4 * (rho >> 3); }

__device__ __forceinline__ void ssm_bu_tile(f32x16 (&acc)[4], const bf16* urow_base  , const bf16x8 (&bfr)[4], int lane) {
    const int rho = lane & 31, h = lane >> 5;
    const bf16x8 a = *(const bf16x8*)(urow_base + (size_t)tok_of_row(rho) * NPROJ + 8 * h);
#pragma unroll
    for (int ct = 0; ct < 4; ++ct) { f32x16 z = {}; acc[ct] = __builtin_amdgcn_mfma_f32_32x32x16_bf16(a, bfr[ct], z, 0, 0, 0); }
}

__device__ __forceinline__ void phase_ssm_pass1(const Args& a, int lane, int wave, int bx, int G) {
    if (wave >= 4) return;
    const bf16* QKVU = (const bf16*)(a.ws + WS_QKVU); const float* LB = (const float*)(a.ws + SSM_LB); const bf16* BBT = (const bf16*)(a.ws + SSM_BBT);
    float* PRE = (float*)(a.ws + WS_PRE); float* TOT = (float*)(a.ws + WS_TOT);
    const int c32 = lane & 31, hi = lane >> 5;
    for (int it = wave * G + bx; it < NB * 16 * NG; it += 4 * G) {
        const int g = it & 31, k = (it >> 5) & 15, b = it >> 9;
        bf16x8 bfr[4];
#pragma unroll
        for (int ct = 0; ct < 4; ++ct) bfr[ct] = *(const bf16x8*)(BBT + ((size_t)(g * 2 + (ct >> 1)) * NP + 32 * (ct & 1) + c32) * NC + 8 * hi);
        cplx l1[2], wA[2], wB[2], l64[2], R[2];
#pragma unroll
        for (int ph = 0; ph < 2; ++ph) { const int gp = g * NP + 32 * ph + c32;
            l1[ph] = ldc(LB + gp * 2); l64[ph] = ldc(LB + (4 * 2048 + gp) * 2);
            wA[ph] = ldc(LB + ((hi ? 2 : 3) * 2048 + gp) * 2);
            wB[ph] = hi ? cplx{1.f, 0.f} : ldc(LB + (1 * 2048 + gp) * 2);
            R[ph] = {0.f, 0.f}; }
        for (int i = 0; i < 8; ++i) {
            const int j = 8 * k + i; const size_t row0 = (size_t)b * SEQ + j * TCH;
            if (hi == 0) {
#pragma unroll
                for (int ph = 0; ph < 2; ++ph) *(float2*)(PRE + ((size_t)((b * NCH + j) * NG + g) * NP + 32 * ph + c32) * 2) = make_float2(R[ph].r, R[ph].i); }
            cplx e[2][2];
#pragma unroll
            for (int T = 0; T < 2; ++T) {
                f32x16 acc[4]; ssm_bu_tile(acc, QKVU + (row0 + 32 * T) * NPROJ + 768 + g * NC, bfr, lane);
#pragma unroll
                for (int ph = 0; ph < 2; ++ph) { cplx h = {0.f, 0.f};
#pragma unroll
                    for (int r = 0; r < 16; ++r) h = cfma(l1[ph], h, cplx{acc[ph][r], acc[2 + ph][r]});
                    e[T][ph] = h; }
            }
#pragma unroll
            for (int ph = 0; ph < 2; ++ph) { cplx v = cmul(wA[ph], e[0][ph]); v = cfma(wB[ph], e[1][ph], v);
                v.r += __shfl_xor(v.r, 32); v.i += __shfl_xor(v.i, 32);
                R[ph] = cfma(l64[ph], R[ph], v); }
        }
        if (hi == 0) {
#pragma unroll
            for (int ph = 0; ph < 2; ++ph) *(float2*)(TOT + ((size_t)((b * 16 + k) * NG + g) * NP + 32 * ph + c32) * 2) = make_float2(R[ph].r, R[ph].i); }
    }
}

constexpr int GS_OFF = 0, HS_OFF = 65536;
__device__ __forceinline__ int gs_addr(int t, int ch) { return GS_OFF + t * 1024 + ((((ch >> 3) ^ (t & 15))) << 4) + (ch & 7) * 2; }
template <bool SAMPLE> __device__ __forceinline__ void ssm_unit_scan(const Args& a, LAS unsigned char* L, int lane, int wave, int unit) {
    const bf16* QKVU = (const bf16*)(a.ws + WS_QKVU); const float* LB = (const float*)(a.ws + SSM_LB); const bf16* BBT = (const bf16*)(a.ws + SSM_BBT); const bf16* CCT = (const bf16*)(a.ws + SSM_CCT);
    const float* PRE = (const float*)(a.ws + WS_PRE); const float* TOT = (const float*)(a.ws + WS_TOT);
    const int c32 = lane & 31, hi = lane >> 5, fr = lane & 15, fq = lane >> 4;
    const int b = unit >> 7, j = unit & 127;
    const size_t row0 = SAMPLE ? (size_t)MP + 64 * unit : (size_t)b * SEQ + j * TCH;
    LAS unsigned char* Hs = L + HS_OFF + wave * 8192;
    for (int gi = 0; gi < 4; ++gi) {
        const int g = wave * 4 + gi;
        bf16x8 bfr[4];
#pragma unroll
        for (int ct = 0; ct < 4; ++ct) bfr[ct] = *(const bf16x8*)(BBT + ((size_t)(g * 2 + (ct >> 1)) * NP + 32 * (ct & 1) + c32) * NC + 8 * hi);
        cplx l1[2], h[2];
#pragma unroll
        for (int ph = 0; ph < 2; ++ph) l1[ph] = ldc(LB + (g * NP + 32 * ph + c32) * 2);
        if (!SAMPLE) {
            const int k = j >> 3, i = j & 7, gp = g * NP + lane;
            const cplx l512 = ldc(LB + (5 * 2048 + gp) * 2), l64 = ldc(LB + (4 * 2048 + gp) * 2);
            cplx E = {0.f, 0.f};
            for (int kk = 0; kk < k; ++kk) E = cfma(l512, E, ldc(TOT + ((size_t)((b * 16 + kk) * NG + g) * NP + lane) * 2));
            cplx w = {1.f, 0.f};
            for (int q = 0; q < i; ++q) w = cmul(w, l64);
            const cplx c = cfma(w, E, ldc(PRE + ((size_t)((b * NCH + j) * NG + g) * NP + lane) * 2));
#pragma unroll
            for (int ph = 0; ph < 2; ++ph) { h[ph].r = __shfl(c.r, 32 * ph + c32); h[ph].i = __shfl(c.i, 32 * ph + c32); }
        }
        bf16x8 cfr[4];
#pragma unroll
        for (int ks = 0; ks < 4; ++ks) cfr[ks] = *(const bf16x8*)(CCT + ((size_t)(g * NC + fr)) * 128 + 32 * ks + 8 * fq);
        const float dv = a.in[17][g * NC + fr];
#pragma unroll 1
        for (int T = 0; T < 2; ++T) {
            f32x16 acc[4]; ssm_bu_tile(acc, QKVU + (row0 + 32 * T) * NPROJ + 768 + g * NC, bfr, lane);
            if (!SAMPLE) {
#pragma unroll
                for (int half = 0; half < 2; ++half) {
                    if (hi == half) {
#pragma unroll
                        for (int ph = 0; ph < 2; ++ph)
#pragma unroll
                            for (int r = 0; r < 16; ++r) { h[ph] = cfma(l1[ph], h[ph], cplx{acc[ph][r], acc[2 + ph][r]}); acc[ph][r] = h[ph].r; acc[2 + ph][r] = h[ph].i; }
                    }
#pragma unroll
                    for (int ph = 0; ph < 2; ++ph) { const float xr = __shfl_xor(h[ph].r, 32), xi = __shfl_xor(h[ph].i, 32); if (hi != half) { h[ph].r = xr; h[ph].i = xi; } }
                }
            } else {
#pragma unroll
                for (int ph = 0; ph < 2; ++ph)
#pragma unroll
                    for (int r = 0; r < 16; ++r) {
                        const int sq = unit * 16 + 8 * T + 4 * hi + (r >> 2); const size_t so = (size_t)(sq * NG + g) * NP + 32 * ph + c32;
                        if ((r & 3) == 0) { h[ph].r = a.in[4][so]; h[ph].i = a.in[5][so]; }
                        h[ph] = cfma(l1[ph], h[ph], cplx{acc[ph][r], acc[2 + ph][r]}); acc[ph][r] = h[ph].r; acc[2 + ph][r] = h[ph].i;
                        if ((r & 3) == 3) { a.out[O_SRS + so] = h[ph].r; a.out[O_SIS + so] = h[ph].i; }
                    }
            }
            asm volatile("s_waitcnt lgkmcnt(0)" ::: "memory");
#pragma unroll
            for (int ph = 0; ph < 2; ++ph)
#pragma unroll
                for (int r = 0; r < 16; ++r) { const int tl = 16 * hi + r, p = 32 * ph + c32;
                    *(LAS unsigned*)(Hs + tl * 256 + (((p >> 2) ^ (tl & 15)) << 4) + (p & 3) * 4) = cvtpk(acc[ph][r], acc[2 + ph][r]); }
            asm volatile("s_waitcnt lgkmcnt(0)" ::: "memory");
#pragma unroll
            for (int mt = 0; mt < 2; ++mt) {
                f32x4 y = {0.f, 0.f, 0.f, 0.f};
#pragma unroll
                for (int ks = 0; ks < 4; ++ks) { const int tl = 16 * mt + fr;
                    const bf16x8 af = *(const LAS bf16x8*)(Hs + tl * 256 + (((4 * ks + fq) ^ (tl & 15)) << 4));
                    y = __builtin_amdgcn_mfma_f32_16x16x32_bf16(af, cfr[ks], y, 0, 0, 0); }
#pragma unroll
                for (int i = 0; i < 4; ++i) { const int tl = 16 * mt + 4 * fq + i, t = 32 * T + tl;
                    const float u = bf2f(QKVU[(row0 + t) * NPROJ + 768 + g * NC + fr]);
                    *(LAS bf16*)(L + gs_addr(t, g * NC + fr)) = (bf16)f2bf(gelu_tanh(y[i] + dv * u)); }
            }
        }
        if (!SAMPLE && j == NCH - 1 && hi == 1) {
#pragma unroll
            for (int ph = 0; ph < 2; ++ph) { const size_t so = (size_t)(b * NG + g) * NP + 32 * ph + c32; a.out[O_SRP + so] = h[ph].r; a.out[O_SIP + so] = h[ph].i; }
        }
    }
}
__device__ __forceinline__ void ssm_unit_glu(const Args& a, LAS unsigned char* L, int tid, int lane, int wave, size_t row0) {
    const bf16* WG = (const bf16*)(a.ws + WS_WGLU);
    bf16* MG = (bf16*)(a.ws + WS_MERGED);
    const int c32 = lane & 31, hi = lane >> 5;
    f32x16 acc[2][2];
#pragma unroll
    for (int nt = 0; nt < 2; ++nt)
#pragma unroll
        for (int tt = 0; tt < 2; ++tt) acc[nt][tt] = f32x16{};
    const bf16* wrow[2]; wrow[0] = WG + (size_t)(64 * wave + c32) * 512 + 32 * hi; wrow[1] = wrow[0] + 32 * 512;
    bf16x8 wa[2][4], wn[2][4];
#pragma unroll
    for (int nt = 0; nt < 2; ++nt)
#pragma unroll
        for (int s = 0; s < 4; ++s) wa[nt][s] = *(const bf16x8*)(wrow[nt] + 8 * s);
#pragma unroll
    for (int kb = 0; kb < 8; ++kb) {
        if (kb < 7) {
#pragma unroll
            for (int nt = 0; nt < 2; ++nt)
#pragma unroll
                for (int s = 0; s < 4; ++s) wn[nt][s] = *(const bf16x8*)(wrow[nt] + 64 * (kb + 1) + 8 * s);
        }
#pragma unroll
        for (int s = 0; s < 4; ++s) {
            bf16x8 gb[2];
#pragma unroll
            for (int tt = 0; tt < 2; ++tt) { const int t = 32 * tt + c32; gb[tt] = *(const LAS bf16x8*)(L + GS_OFF + t * 1024 + (((8 * kb + 4 * hi + s) ^ (t & 15)) << 4)); }
#pragma unroll
            for (int nt = 0; nt < 2; ++nt)
#pragma unroll
                for (int tt = 0; tt < 2; ++tt) acc[nt][tt] = __builtin_amdgcn_mfma_f32_32x32x16_bf16(wa[nt][s], gb[tt], acc[nt][tt], 0, 0, 0);
        }
        if (kb < 7) {
#pragma unroll
            for (int nt = 0; nt < 2; ++nt)
#pragma unroll
                for (int s = 0; s < 4; ++s) wa[nt][s] = wn[nt][s];
        }
    }
    __syncthreads();
    float ssq[2] = {0.f, 0.f};
#pragma unroll
    for (int nt = 0; nt < 2; ++nt)
#pragma unroll
        for (int q4 = 0; q4 < 4; ++q4) { const int n0 = 64 * wave + 32 * nt + 8 * q4 + 4 * hi; const f32x4 bv = *(const f32x4*)(a.in[19] + n0);
#pragma unroll
            for (int tt = 0; tt < 2; ++tt) { const int t = 32 * tt + c32; LAS u32x2* gp = (LAS u32x2*)(L + gs_addr(t, n0)); const u32x2 gw = *gp;
                float o[4];
#pragma unroll
                for (int e = 0; e < 4; ++e) { const float gv = __uint_as_float(((e & 1) ? (gw[e >> 1] & 0xffff0000u) : (gw[e >> 1] << 16))); const float z = acc[nt][tt][4 * q4 + e] + bv[e];
                    o[e] = gv / (1.f + __expf(-z)); ssq[tt] += o[e] * o[e]; }
                u32x2 ow; ow[0] = cvtpk(o[0], o[1]); ow[1] = cvtpk(o[2], o[3]); *gp = ow; }
        }
    LAS float* SS = (LAS float*)(L + HS_OFF);
#pragma unroll
    for (int tt = 0; tt < 2; ++tt) { const float s = ssq[tt] + __shfl_xor(ssq[tt], 32); if (hi == 0) SS[wave * 64 + 32 * tt + c32] = s; }
    __syncthreads();
    {
        const int t = tid >> 3, part = tid & 7; float s = 0.f;
#pragma unroll
        for (int w = 0; w < 8; ++w) s += SS[w * 64 + t];
        const float rstd = 1.f / sqrtf(s * (1.f / 512.f) + 1e-6f);
        bf16* dst = MG + (row0 + t) * 1024 + 512 + 64 * part; const float* gn = a.in[21] + 64 * part;
#pragma unroll
        for (int c = 0; c < 8; ++c) { const v4u v = *(const LAS v4u*)(L + GS_OFF + t * 1024 + (((8 * part + c) ^ (t & 15)) << 4)); const f32x4 g0 = *(const f32x4*)(gn + 8 * c), g1 = *(const f32x4*)(gn + 8 * c + 4);
            v4u o; o.x = cvtpk(__uint_as_float(v.x << 16) * rstd * g0.x, __uint_as_float(v.x & 0xffff0000u) * rstd * g0.y); o.y = cvtpk(__uint_as_float(v.y << 16) * rstd * g0.z, __uint_as_float(v.y & 0xffff0000u) * rstd * g0.w);
            o.z = cvtpk(__uint_as_float(v.z << 16) * rstd * g1.x, __uint_as_float(v.z & 0xffff0000u) * rstd * g1.y); o.w = cvtpk(__uint_as_float(v.w << 16) * rstd * g1.z, __uint_as_float(v.w & 0xffff0000u) * rstd * g1.w);
            *(v4u*)(dst + 8 * c) = o; }
    }
    __syncthreads();
}
__device__ __forceinline__ void phase_ssm_pass2(const Args& a, LAS unsigned char* L, int tid0, int wave, int bx, int G) {
    for (int u = bx; u < 256 + 8; u += G) {
        int tid = tid0; asm volatile("" : "+v"(tid));
        const int lane = tid & 63;
        if (u < 256) { ssm_unit_scan<false>(a, L, lane, wave, u); __syncthreads(); int t2 = tid; asm volatile("" : "+v"(t2)); ssm_unit_glu(a, L, t2, t2 & 63, wave, (size_t)(u >> 7) * SEQ + (u & 127) * TCH); }
        else { ssm_unit_scan<true>(a, L, lane, wave, u - 256); __syncthreads(); int t2 = tid; asm volatile("" : "+v"(t2)); ssm_unit_glu(a, L, t2, t2 & 63, wave, (size_t)MP + 64 * (u - 256)); }
    }
}

typedef short v4i16_t __attribute__((ext_vector_type(4)));
constexpr float LOG2E = 1.4426950408889634f;
constexpr int AK_OFF = 0, AV_OFF = 24576, AO_OFF = 49152, ABT_OFF = 114688, ALI_OFF = ABT_OFF + 8 * 192 * 4;
__device__ __forceinline__ int crow(int r, int hi) { return (r & 3) + 8 * (r >> 2) + 4 * hi; }
__device__ __forceinline__ void attn_build_table(const Args& a, LAS unsigned char* L, int tid) {
    LAS float* BT = (LAS float*)(L + ABT_OFF);
    for (int e = tid; e < 8 * 192; e += 512) { const int h = e / 192, dist = e % 192 - 32; BT[e] = (dist >= 0 && dist < 128) ? a.in[6][rel_bucket(dist) * 8 + h] * LOG2E : -1e30f; }
}
__device__ __forceinline__ void attn_unit(const Args& a, LAS unsigned char* L, int tid, int lane, int wave, int unit) {
    const bf16* QKVU = (const bf16*)(a.ws + WS_QKVU); bf16* MG = (bf16*)(a.ws + WS_MERGED);
    const int qh = unit & 1, n = (unit >> 1) & 63, b = unit >> 7;
    const int c32 = lane & 31, hi = lane >> 5;
    const int rh = wave >> 1, qg = 2 * qh + (wave & 1);
    const size_t qrow = (size_t)b * SEQ + n * 128 + 32 * qg + c32;
    const size_t blk0 = (size_t)b * SEQ + (size_t)(n - 1) * 128;
    LAS const float* BT = (LAS const float*)(L + ABT_OFF);
    LAS float* LI = (LAS float*)(L + ALI_OFF) + wave * 32;
    for (int g = 0; g < 2; ++g) {
        for (int pc = wave * 6; pc < wave * 6 + 6; ++pc) {
            if (pc < 24) { const int lt = pc >> 2, cp = pc & 3, chunk = 2 * cp + (lane >> 5), key = lane & 31; int j = 64 * qh + 32 * lt + key; if (n == 0 && j < 128) j += 128;
                const v4u v = *(const v4u*)(QKVU + (blk0 + j) * NPROJ + 512 + g * 64 + chunk * 8);
                *(LAS v4u*)(L + AK_OFF + lt * 4096 + cp * 1024 + lane * 16) = v; }
            else { const int q = pc - 24, lt = q >> 2, dh = (q >> 1) & 1, ks = q & 1, key = lane >> 2, c4 = lane & 3; int j = 64 * qh + 32 * lt + 16 * ks + key; if (n == 0 && j < 128) j += 128;
                const v4u v = *(const v4u*)(QKVU + (blk0 + j) * NPROJ + 640 + g * 64 + dh * 32 + c4 * 8);
                *(LAS v4u*)(L + AV_OFF + lt * 4096 + dh * 2048 + ks * 1024 + lane * 16) = v; }
        }
        const int h = 4 * g + rh;
        bf16x8 qf[4];
#pragma unroll
        for (int d0 = 0; d0 < 4; ++d0) qf[d0] = *(const bf16x8*)(QKVU + qrow * NPROJ + h * 64 + 16 * d0 + 8 * hi);
        __syncthreads();
        f32x16 S[5];
#pragma unroll
        for (int tl = 0; tl < 5; ++tl) { S[tl] = f32x16{};
            LAS const unsigned char* Kt = L + AK_OFF + ((wave & 1) + tl) * 4096 + hi * 512 + c32 * 16;
#pragma unroll
            for (int d0 = 0; d0 < 4; ++d0) S[tl] = __builtin_amdgcn_mfma_f32_32x32x16_bf16(*(LAS const bf16x8*)(Kt + d0 * 1024), qf[d0], S[tl], 0, 0, 0); }
        const float sink2 = a.in[9][h] * LOG2E; float m = sink2;
#pragma unroll
        for (int tl = 0; tl < 5; ++tl) { const bool dead = (n == 0) && (qg + tl < 4);
#pragma unroll
            for (int r = 0; r < 16; ++r) { const int x = c32 + 160 - 32 * tl - crow(r, hi);
                const float s = dead ? -1e30f : S[tl][r] * (0.125f * LOG2E) + BT[h * 192 + x]; S[tl][r] = s; m = fmaxf(m, s); } }
        m = fmaxf(m, __shfl_xor(m, 32));
        float l = 0.f;
#pragma unroll
        for (int tl = 0; tl < 5; ++tl)
#pragma unroll
            for (int r = 0; r < 16; ++r) { const float p = __builtin_amdgcn_exp2f(S[tl][r] - m); S[tl][r] = p; l += p; }
        l += __shfl_xor(l, 32); l += __builtin_amdgcn_exp2f(sink2 - m);
        if (hi == 0) LI[c32] = 1.f / l;
        f32x16 o[2]; o[0] = f32x16{}; o[1] = f32x16{};
        const int vb = ((lane >> 4) & 1) * 32 + (lane & 3) * 8 + (4 * hi + ((lane & 15) >> 2)) * 64;
#pragma unroll
        for (int tl = 0; tl < 5; ++tl) { LAS const unsigned char* Vt = L + AV_OFF + ((wave & 1) + tl) * 4096 + vb;
#pragma unroll
            for (int ks = 0; ks < 2; ++ks) {
                v4u pw; pw.x = cvtpk(S[tl][8 * ks + 0], S[tl][8 * ks + 1]); pw.y = cvtpk(S[tl][8 * ks + 2], S[tl][8 * ks + 3]); pw.z = cvtpk(S[tl][8 * ks + 4], S[tl][8 * ks + 5]); pw.w = cvtpk(S[tl][8 * ks + 6], S[tl][8 * ks + 7]);
                const bf16x8 pa = __builtin_bit_cast(bf16x8, pw);
#pragma unroll
                for (int d0 = 0; d0 < 2; ++d0) {
                    const v4i16_t lo = __builtin_amdgcn_ds_read_tr16_b64_v4i16((LAS v4i16_t*)(Vt + d0 * 2048 + ks * 1024));
                    const v4i16_t hv = __builtin_amdgcn_ds_read_tr16_b64_v4i16((LAS v4i16_t*)(Vt + d0 * 2048 + ks * 1024 + 512));
                    const bf16x8 vf = {lo[0], lo[1], lo[2], lo[3], hv[0], hv[1], hv[2], hv[3]};
                    o[d0] = __builtin_amdgcn_mfma_f32_32x32x16_bf16(pa, vf, o[d0], 0, 0, 0); } } }
        asm volatile("s_waitcnt lgkmcnt(0)" ::: "memory");
#pragma unroll
        for (int r = 0; r < 16; ++r) { const int q = crow(r, hi); const float li = LI[q];
#pragma unroll
            for (int d0 = 0; d0 < 2; ++d0) *(LAS bf16*)(L + AO_OFF + (32 * (wave & 1) + q) * 1024 + (h * 64 + 32 * d0 + c32) * 2) = (bf16)f2bf(o[d0][r] * li); }
        __syncthreads();
    }
    {
        const int t = tid >> 3, part = tid & 7; v4u v[8]; float s = 0.f;
#pragma unroll
        for (int c = 0; c < 8; ++c) { v[c] = *(LAS const v4u*)(L + AO_OFF + t * 1024 + part * 128 + ((c + part) & 7) * 16);
#pragma unroll
            for (int e = 0; e < 4; ++e) { const float x0 = __uint_as_float(v[c][e] << 16), x1 = __uint_as_float(v[c][e] & 0xffff0000u); s += x0 * x0 + x1 * x1; } }
        s += __shfl_xor(s, 1); s += __shfl_xor(s, 2); s += __shfl_xor(s, 4);
        const float rstd = 1.f / sqrtf(s * (1.f / 512.f) + 1e-6f);
        bf16* dst = MG + ((size_t)b * SEQ + n * 128 + 64 * qh + t) * 1024 + 64 * part; const float* gn = a.in[20] + 64 * part;
#pragma unroll
        for (int c = 0; c < 8; ++c) { const int cc = (c + part) & 7; const f32x4 g0 = *(const f32x4*)(gn + 8 * cc), g1 = *(const f32x4*)(gn + 8 * cc + 4); const v4u x = v[c];
            v4u w; w.x = cvtpk(__uint_as_float(x.x << 16) * rstd * g0.x, __uint_as_float(x.x & 0xffff0000u) * rstd * g0.y); w.y = cvtpk(__uint_as_float(x.y << 16) * rstd * g0.z, __uint_as_float(x.y & 0xffff0000u) * rstd * g0.w);
            w.z = cvtpk(__uint_as_float(x.z << 16) * rstd * g1.x, __uint_as_float(x.z & 0xffff0000u) * rstd * g1.y); w.w = cvtpk(__uint_as_float(x.w << 16) * rstd * g1.z, __uint_as_float(x.w & 0xffff0000u) * rstd * g1.w);
            *(v4u*)(dst + 8 * cc) = w; }
    }
    __syncthreads();
}
__device__ __forceinline__ void attn_sample_item(const Args& a, int lane, int it) {
    const bf16* QKVU = (const bf16*)(a.ws + WS_QKVU); bf16* MG = (bf16*)(a.ws + WS_MERGED);
    const float* ck = a.in[2]; const float* cv = a.in[3];
    const int s = it >> 2, i = it & 3; const size_t qrow = (size_t)MP + s * 4 + i;
    float oh[8]; float ss = 0.f;
    const int jj0 = i + 1 + lane, jj1 = i + 65 + lane;
    const int b0 = rel_bucket(127 - lane), b1 = rel_bucket(63 - lane);
#pragma unroll
    for (int h = 0; h < 8; ++h) { const int g = h >> 2;
        float q[64];
#pragma unroll
        for (int c = 0; c < 8; ++c) { const v4u v = *(const v4u*)(QKVU + qrow * NPROJ + h * 64 + 8 * c);
#pragma unroll
            for (int e = 0; e < 4; ++e) { q[8 * c + 2 * e] = __uint_as_float(v[e] << 16); q[8 * c + 2 * e + 1] = __uint_as_float(v[e] & 0xffff0000u); } }
        float sc[2];
#pragma unroll
        for (int kk = 0; kk < 2; ++kk) { const int jj = kk ? jj1 : jj0; float d = 0.f;
            if (jj < 128) { const f32x4* kp = (const f32x4*)(ck + ((size_t)(s * 128 + jj) * 2 + g) * 64);
#pragma unroll
                for (int c = 0; c < 16; ++c) { const f32x4 kv = kp[c]; d += q[4 * c] * kv.x + q[4 * c + 1] * kv.y + q[4 * c + 2] * kv.z + q[4 * c + 3] * kv.w; } }
            else { const bf16* kp = QKVU + ((size_t)MP + s * 4 + (jj - 128)) * NPROJ + 512 + g * 64;
#pragma unroll
                for (int c = 0; c < 8; ++c) { const v4u v = *(const v4u*)(kp + 8 * c);
#pragma unroll
                    for (int e = 0; e < 4; ++e) d += q[8 * c + 2 * e] * __uint_as_float(v[e] << 16) + q[8 * c + 2 * e + 1] * __uint_as_float(v[e] & 0xffff0000u); } }
            sc[kk] = d * 0.125f + a.in[6][(kk ? b1 : b0) * 8 + h]; }
        const float sink = a.in[9][h];
        float m = fmaxf(sc[0], sc[1]);
#pragma unroll
        for (int o = 1; o < 64; o <<= 1) m = fmaxf(m, __shfl_xor(m, o));
        m = fmaxf(m, sink);
        const float p0 = __expf(sc[0] - m), p1 = __expf(sc[1] - m);
        const float l = wave_sum(p0 + p1) + __expf(sink - m);
        float o = 0.f;
#pragma unroll 4
        for (int kx = 0; kx < 128; ++kx) { const int jj = i + 1 + kx; const float p = __shfl(kx < 64 ? p0 : p1, kx & 63);
            const float vv = (jj < 128) ? cv[((size_t)(s * 128 + jj) * 2 + g) * 64 + lane] : bf2f(QKVU[((size_t)MP + s * 4 + (jj - 128)) * NPROJ + 640 + g * 64 + lane]);
            o += p * vv; }
        o /= l; oh[h] = o; ss += o * o;
    }
    const float rstd = 1.f / sqrtf(wave_sum(ss) * (1.f / 512.f) + 1e-6f);
#pragma unroll
    for (int h = 0; h < 8; ++h) MG[qrow * 1024 + h * 64 + lane] = (bf16)f2bf(oh[h] * rstd * a.in[20][h * 64 + lane]);
}
__device__ __forceinline__ void phase_prologue(const Args& a, LAS unsigned char* L, int tid, int lane, int wave, int bx, int G) {
    unsigned char* ws = a.ws;
    LAS float* scr = (LAS float*)L + wave * 64 * 33;
    const int gw = bx * 8 + wave, NGW = G * 8;
    constexpr int I_IN = (1024 / 64) * (1280 / 32), I_OUT = (1024 / 64) * (1024 / 32), I_UP = (1024 / 64) * (4096 / 32), I_DN = (4096 / 64) * (1024 / 32), I_GLU = (512 / 64) * (512 / 32);
    constexpr int NITEMS = I_IN + I_OUT + I_UP + I_DN + I_GLU;
    for (int it = gw; it < NITEMS; it += NGW) {
        int r = it;
        if (r < I_IN) { p0_transpose_item(a.in[8], 1024, 1280, (bf16*)(ws + WS_WIN), scr, r, lane); continue; } r -= I_IN;
        if (r < I_OUT) { p0_transpose_item(a.in[22], 1024, 1024, (bf16*)(ws + WS_WOUT), scr, r, lane); continue; } r -= I_OUT;
        if (r < I_UP) { p0_transpose_item(a.in[24], 1024, 4096, (bf16*)(ws + WS_WUP), scr, r, lane); continue; } r -= I_UP;
        if (r < I_DN) { p0_transpose_item(a.in[25], 4096, 1024, (bf16*)(ws + WS_WDN), scr, r, lane); continue; } r -= I_DN;
        p0_transpose_item(a.in[18], 512, 512, (bf16*)(ws + WS_WGLU), scr, r, lane);
    }
    bf16* XN = (bf16*)(ws + WS_XN);
    for (int m = gw; m < M; m += NGW) { const float* xr = m < MP ? a.in[0] + (size_t)m * DM : a.in[1] + (size_t)(m - MP) * DM; rms_row_to_bf16(xr, a.in[7], XN + (size_t)m * DM, lane); }
    const int gt = bx * 512 + tid;
    if (gt < NG * NP) {
        const int g = gt / NP, p = gt % NP;
        const double step = exp((double)a.in[12][g]); const double ar = a.in[10][gt], ai = a.in[11][gt];
        float* LBp = (float*)(ws + SSM_LB);
        const int ex[6] = {1, 16, 32, 48, 64, 512};
        double lr = 0, li = 0;
#pragma unroll
        for (int e = 0; e < 6; ++e) { const double mag = exp(ar * step * ex[e]), r_ = mag * cos(ai * step * ex[e]), i_ = mag * sin(ai * step * ex[e]); if (e == 0) { lr = r_; li = i_; }
            LBp[(e * 2048 + gt) * 2] = (float)r_; LBp[(e * 2048 + gt) * 2 + 1] = (float)i_; }
        const double den = ar * ar + ai * ai; const double cr = ((lr - 1.0) * ar + li * ai) / den, ci = (li * ar - (lr - 1.0) * ai) / den;
        bf16* BBT = (bf16*)(ws + SSM_BBT); bf16* CCT = (bf16*)(ws + SSM_CCT);
        for (int c = 0; c < NC; ++c) { const double br = a.in[13][gt * NC + c], bi = a.in[14][gt * NC + c];
            BBT[((size_t)(g * 2 + 0) * NP + p) * NC + c] = (bf16)f2bf((float)(cr * br - ci * bi)); BBT[((size_t)(g * 2 + 1) * NP + p) * NC + c] = (bf16)f2bf((float)(cr * bi + ci * br));
            CCT[((size_t)(g * NC + c)) * 128 + 2 * p] = (bf16)f2bf(a.in[15][(g * NC + c) * NP + p]); CCT[((size_t)(g * NC + c)) * 128 + 2 * p + 1] = (bf16)f2bf(-a.in[16][(g * NC + c) * NP + p]); }
    }
    { const int nthreads = G * 512; const int total = 128 * 124 * 32;
        for (int i = bx * 512 + tid; i < total; i += nthreads) { const int q = i & 31, sw = i >> 5, s = sw / 124, w = sw % 124;
            const size_t src = ((size_t)(s * 128 + w + 4) * 128) / 4 + q, dst = ((size_t)(s * 128 + w) * 128) / 4 + q;
            ((f32x4*)(a.out + O_KS))[dst] = ((const f32x4*)a.in[2])[src]; ((f32x4*)(a.out + O_VS))[dst] = ((const f32x4*)a.in[3])[src]; } }
}

__device__ __forceinline__ void phase_rms_final(const Args& a, int lane, int gw, int NGW) {
    for (int row = gw; row < M; row += NGW) {
        f32x4* xr = (f32x4*)(a.out + (size_t)row * DM) + lane; const f32x4* gr = (const f32x4*)a.in[26] + lane;
        f32x4 v[4]; float s = 0.f;
#pragma unroll
        for (int j = 0; j < 4; ++j) { v[j] = xr[64 * j]; s += (v[j].x * v[j].x + v[j].y * v[j].y) + (v[j].z * v[j].z + v[j].w * v[j].w); }
        const float rstd = 1.f / sqrtf(wave_sum(s) * (1.f / 1024.f) + 1e-6f);
#pragma unroll
        for (int j = 0; j < 4; ++j) xr[64 * j] = v[j] * rstd * gr[64 * j];
    }
}

__global__ void __launch_bounds__(512, 2) mk_fwd(Args a) {
    extern __shared__ __attribute__((aligned(16))) unsigned char lds[];
    LAS unsigned char* L = (LAS unsigned char*)lds;
    const int tid = threadIdx.x, lane = tid & 63, wave = __builtin_amdgcn_readfirstlane(tid >> 6);
    const int G = gridDim.x, bx = blockIdx.x, gw = bx * 8 + wave, NGW = G * 8;
    for (int u = tid; u < (LDS_BYTES - LDSCTL_OFF) / 4; u += 512) ((LAS unsigned*)(L + LDSCTL_OFF))[u] = 0u;
    __syncthreads();
    unsigned* ctl = (unsigned*)(a.ws + WS_CTL);
    XcdBarrier bar = xcd_barrier_post(ctl + CW_BAR, (volatile LAS unsigned*)(L + MISC_OFF) + 8);
    unsigned char* ws = a.ws;
    bf16 *XN = (bf16*)(ws + WS_XN), *QKVU = (bf16*)(ws + WS_QKVU), *MG = (bf16*)(ws + WS_MERGED), *H = (bf16*)(ws + WS_H);
    PG8_LAS unsigned char* RL = (PG8_LAS unsigned char*)lds;

    phase_prologue(a, L, tid, lane, wave, bx, G);
    xcd_barrier(bar);
    { pg8::Gemm g{XN, (const bf16*)(ws + WS_WIN), M, NPROJ, DM}; pg8::StaticOrder S; S.init(M, NPROJ, G, bx);
      pg8::gemm_phase<pg8::EpiInProj, pg8::StaticOrder, true, true>(RL, g, S, pg8::EpiInProj{QKVU, a.out, NPROJ, 0}); }
    xcd_barrier(bar);
    attn_build_table(a, L, tid);
    __syncthreads();
    for (int u = bx; u < 256; u += G) attn_unit(a, L, tid, lane, wave, u);
    phase_ssm_pass1(a, lane, wave, bx, G);
    if (wave == 4 || wave == 5) for (int it = (wave - 4) * G + bx; it < 512; it += 2 * G) attn_sample_item(a, lane, it);
    xcd_barrier(bar);
    phase_ssm_pass2(a, L, tid, wave, bx, G);
    xcd_barrier(bar);
    { pg8::Gemm g{MG, (const bf16*)(ws + WS_WOUT), M, DM, DM}; pg8::StaticOrder S; S.init(M, DM, G, bx);
      pg8::gemm_phase<pg8::EpiF32Res, pg8::StaticOrder, true, true>(RL, g, S, pg8::EpiF32Res{a.in[0], a.in[1], a.out, DM, 0}); }
    xcd_barrier(bar);
    for (int m = gw; m < M; m += NGW) rms_row_to_bf16(a.out + (size_t)m * DM, a.in[23], XN + (size_t)m * DM, lane);
    xcd_barrier(bar);
    { pg8::Gemm g{XN, (const bf16*)(ws + WS_WUP), M, FF, DM}; pg8::StaticOrder S; S.init(M, FF, G, bx);
      pg8::gemm_phase<pg8::EpiRelu2, pg8::StaticOrder, true, true>(RL, g, S, pg8::EpiRelu2{H, FF, 0}); }
    xcd_barrier(bar);
    { pg8::Gemm g{H, (const bf16*)(ws + WS_WDN), M, DM, FF}; pg8::StaticOrder S; S.init(M, DM, G, bx);
      pg8::gemm_phase<pg8::EpiF32Res, pg8::StaticOrder, true, true>(RL, g, S, pg8::EpiF32Res{a.out, a.out + (size_t)MP * DM, a.out, DM, 0}); }
    xcd_barrier(bar);
    phase_rms_final(a, lane, gw, NGW);
}

extern "C" void kernel_launch(void* const* d_in, const int* in_sizes, int n_in, void* d_out, int out_size, void* d_ws, size_t ws_size, hipStream_t stream) {
    static int grid = 0;
    if (grid == 0) {
        if (n_in != 27 || out_size != 22093824 || ws_size < WS_END) { fprintf(stderr, "kernel_launch: unexpected sizes n_in %d out %d ws %zu\n", n_in, out_size, ws_size); grid = -1; return; }
        int dev = 0, cus = 0, per_cu = 0;
        if (hipGetDevice(&dev) != hipSuccess || hipDeviceGetAttribute(&cus, hipDeviceAttributeMultiprocessorCount, dev) != hipSuccess) { grid = -1; return; }
        if (hipFuncSetAttribute((const void*)mk_fwd, hipFuncAttributeMaxDynamicSharedMemorySize, LDS_BYTES) != hipSuccess) { fprintf(stderr, "kernel_launch: hipFuncSetAttribute failed\n"); grid = -1; return; }
        if (hipOccupancyMaxActiveBlocksPerMultiprocessor(&per_cu, (const void*)mk_fwd, 512, LDS_BYTES) != hipSuccess || per_cu < 1) fprintf(stderr, "kernel_launch: occupancy query reports %d\n", per_cu);
        (void)hipGetLastError();
        grid = cus;
    }
    if (grid < 0) return;
    if (hipMemsetAsync((char*)d_ws + WS_CTL, 0, CTL_ZERO_BYTES, stream) != hipSuccess) return;
    Args a{};
    for (int i = 0; i < 27; ++i) a.in[i] = (const float*)d_in[i];
    a.out = (float*)d_out; a.ws = (unsigned char*)d_ws;
    hipLaunchKernelGGL(mk_fwd, dim3(grid), dim3(512), LDS_BYTES, stream, a);
}
```

```cpp
#include <hip/hip_runtime.h>
#include <cstdio>
#include <cstdint>
namespace pg8 {
#define PG8_LAS __attribute__((address_space(3)))
typedef unsigned short bf16_t;
typedef short bf16x8 __attribute__((ext_vector_type(8)));
typedef float f32x4 __attribute__((ext_vector_type(4)));
typedef unsigned u32x4 __attribute__((ext_vector_type(4)));
constexpr int BM = 256, BK = 64, HALF = 128, HTB = HALF * BK * 2  , STAGE_BYTES = 8 * HTB, NXCD = 8, WGM = 8;

__host__ __device__ __forceinline__ int lds_byte(int r, int c) { const int st = (r >> 4) * 2 + (c >> 5), rr = r & 15, cc = c & 31, ob = rr * 64 + cc * 2; return st * 1024 + (ob ^ (((ob >> 9) & 1) << 5)); }
__host__ __device__ __forceinline__ void stage_rc(int b, int& R, int& C) { const int st = b / 1024, sb = b % 1024, swz = sb ^ (((sb >> 9) & 1) << 5); R = (st >> 1) * 16 + swz / 64; C = (st & 1) * 32 + (swz % 64) / 2; }
__host__ __device__ __forceinline__ int perm32(int rho) { const int n = rho >> 4, i = rho & 15; return 8 * (i >> 2) + 4 * n + (i & 3); }

struct Unit { int pm, pn; };
struct Gemm { const bf16_t* A; const bf16_t* Bt; int M, N, K; };

struct StaticOrder {
    int nM, nN, nwg, G, c;
    __host__ __device__ void init(int M, int N, int G_, int c_) { nM = M / BM; nN = N / BM; nwg = nM * nN; G = G_; c = c_; }
    __host__ __device__ bool next(int i, Unit& u) const {
        const long L = (long)i * G + c; if (L >= nwg) return false;
        int wgid = (int)L; { const int q = nwg / NXCD, r = nwg % NXCD, xcd = wgid % NXCD, off = wgid / NXCD; wgid = (xcd < r ? xcd * (q + 1) : r * (q + 1) + (xcd - r) * q) + off; }
        const int nig = WGM * nN, gid = wgid / nig, fm = gid * WGM, gsz = (nM - fm) < WGM ? (nM - fm) : WGM;
        u.pm = fm + ((wgid % nig) % gsz); u.pn = (wgid % nig) / gsz; return true;
    }
    __device__ __forceinline__ void a_ready(const Unit&) const {}
    __device__ __forceinline__ void done(const Unit&) const {}
};


__device__ __forceinline__ unsigned cvt_pk_bf16(float lo, float hi) { unsigned r; asm volatile("v_cvt_pk_bf16_f32 %0, %1, %2" : "=v"(r) : "v"(lo), "v"(hi)); return r; }

struct EpiInProj {
    static constexpr bool PERM = true, AFTER_DRAIN = false;
    bf16_t* O; float* out; int ldc; int pad;
    __device__ __forceinline__ void operator()(const f32x4 (&acc)[2][2][4][2], const Unit& u, int wr, int wc, int fr, int fq) const {
        const int row0 = u.pm * BM + wr * 64 + fr; const int col0 = u.pn * BM + wc * 32 + 8 * fq;
#pragma unroll
        for (int ai = 0; ai < 2; ++ai)
#pragma unroll
            for (int m = 0; m < 4; ++m) { const int row = row0 + ai * HALF + m * 16; bf16_t* rowp = O + (size_t)row * ldc + col0;
#pragma unroll
                for (int bj = 0; bj < 2; ++bj) { const f32x4 v0 = acc[ai][bj][m][0], v1 = acc[ai][bj][m][1];
                    u32x4 w; w.x = cvt_pk_bf16(v0[0], v0[1]); w.y = cvt_pk_bf16(v0[2], v0[3]); w.z = cvt_pk_bf16(v1[0], v1[1]); w.w = cvt_pk_bf16(v1[2], v1[3]);
                    *(u32x4*)(rowp + bj * HALF) = w; }
            }
    }
};
struct EpiF32Res {
    static constexpr bool PERM = false, AFTER_DRAIN = false;
    const float* b0; const float* b1; float* O; int ldc; int pad;
    __device__ __forceinline__ void operator()(const f32x4 (&acc)[2][2][4][2], const Unit& u, int wr, int wc, int fr, int fq) const {
        const int row0 = u.pm * BM + wr * 64 + fr; const int col0 = u.pn * BM + wc * 32 + 4 * fq;
#pragma unroll
        for (int ai = 0; ai < 2; ++ai)
#pragma unroll
            for (int m = 0; m < 4; ++m) { const int row = row0 + ai * HALF + m * 16;
                const float* bp = (row < 16384 ? b0 + (size_t)row * ldc : b1 + (size_t)(row - 16384) * ldc) + col0; float* op = O + (size_t)row * ldc + col0;
#pragma unroll
                for (int bj = 0; bj < 2; ++bj)
#pragma unroll
                    for (int n = 0; n < 2; ++n) { const f32x4 bs = *(const f32x4*)(bp + bj * HALF + n * 16); *(f32x4*)(op + bj * HALF + n * 16) = bs + acc[ai][bj][m][n]; }
            }
    }
};
struct EpiRelu2 {
    static constexpr bool PERM = true, AFTER_DRAIN = false;
    bf16_t* O; int ldc; int pad;
    __device__ __forceinline__ void operator()(const f32x4 (&acc)[2][2][4][2], const Unit& u, int wr, int wc, int fr, int fq) const {
        const int row0 = u.pm * BM + wr * 64 + fr; const int col0 = u.pn * BM + wc * 32 + 8 * fq;
#pragma unroll
        for (int ai = 0; ai < 2; ++ai)
#pragma unroll
            for (int m = 0; m < 4; ++m) { bf16_t* rowp = O + (size_t)(row0 + ai * HALF + m * 16) * ldc + col0;
#pragma unroll
                for (int bj = 0; bj < 2; ++bj) { f32x4 v0 = acc[ai][bj][m][0], v1 = acc[ai][bj][m][1];
#pragma unroll
                    for (int j = 0; j < 4; ++j) { const float a = fmaxf(v0[j], 0.f), b = fmaxf(v1[j], 0.f); v0[j] = a * a; v1[j] = b * b; }
                    u32x4 w; w.x = cvt_pk_bf16(v0[0], v0[1]); w.y = cvt_pk_bf16(v0[2], v0[3]); w.z = cvt_pk_bf16(v1[0], v1[1]); w.w = cvt_pk_bf16(v1[2], v1[3]);
                    *(u32x4*)(rowp + bj * HALF) = w; } }
    }
};
__device__ __forceinline__ float bf2f(bf16_t b) { return __uint_as_float((unsigned)b << 16); }
struct EpiGlu {
    static constexpr bool PERM = false, AFTER_DRAIN = false;
    const bf16_t* G; const float* bias; float* O; int ldc; int pad;
    __device__ __forceinline__ void operator()(const f32x4 (&acc)[2][2][4][2], const Unit& u, int wr, int wc, int fr, int fq) const {
        const int row0 = u.pm * BM + wr * 64 + fr; const int col0 = u.pn * BM + wc * 32 + 4 * fq;
#pragma unroll
        for (int ai = 0; ai < 2; ++ai)
#pragma unroll
            for (int m = 0; m < 4; ++m) { const size_t ro = (size_t)(row0 + ai * HALF + m * 16) * ldc + col0;
#pragma unroll
                for (int bj = 0; bj < 2; ++bj)
#pragma unroll
                    for (int n = 0; n < 2; ++n) { const int co = bj * HALF + n * 16; const f32x4 bv = *(const f32x4*)(bias + col0 + co);
                        const unsigned long long gw = *(const unsigned long long*)(G + ro + co); f32x4 o;
#pragma unroll
                        for (int j = 0; j < 4; ++j) { const float g = bf2f((bf16_t)(gw >> (16 * j))); const float z = acc[ai][bj][m][n][j] + bv[j]; o[j] = g / (1.f + __expf(-z)); }
                        *(f32x4*)(O + ro + co) = o; }
            }
    }
};
template <class Epi, class Sched, bool ALIGN_EPI = false, bool SP2 = false>
__device__ __forceinline__ void gemm_phase(PG8_LAS unsigned char* lds, const Gemm g, const Sched& S, const Epi& E) {
    int tid_ = threadIdx.x; asm volatile("" : "+v"(tid_));
    const int tid = tid_, wid = __builtin_amdgcn_readfirstlane(tid >> 6), lane = tid & 63, wr = wid >> 2, wc = wid & 3, fr = lane & 15, fq = lane >> 4;
    const int K = g.K, nt = K / BK;
    unsigned voffA[2], voffB[2];
#pragma unroll
    for (int i = 0; i < 2; ++i) { int R, C; stage_rc(tid * 16 + i * 8192, R, C); const int Rb = Epi::PERM ? ((R & ~31) + perm32(R & 31)) : R;
        voffA[i] = (unsigned)(R * K + C) * 2u; voffB[i] = (unsigned)(Rb * K + C) * 2u; }
    const size_t kstep = (size_t)(BK * 2);
    const size_t hstep = (size_t)HALF * K * 2;
    const size_t tstep = 2 * hstep;
    const unsigned ldsw = (unsigned)wid * 1024u;
    const int aoff = lds_byte(wr * 64 + fr, fq * 8), boff = lds_byte(wc * 32 + fr, fq * 8);
#define PG8_SA(b, h) (((b) * 2 + (h)) * HTB)
#define PG8_SB(b, h) ((4 + (b) * 2 + (h)) * HTB)
#define PG8_STAGE(bufoff, gbase, voff) do { _Pragma("unroll") for (int _i = 0; _i < 2; ++_i) \
        __builtin_amdgcn_global_load_lds((const unsigned*)((const char*)(gbase) + (voff)[_i]), (PG8_LAS unsigned*)(lds + (bufoff) + ldsw + _i * 8192), 16, 0, 0); } while (0)
#define PG8_LDA(dst, b, h) do { _Pragma("unroll") for (int m = 0; m < 4; ++m) _Pragma("unroll") for (int k = 0; k < 2; ++k) dst[m][k] = *(const PG8_LAS bf16x8*)(lds + PG8_SA(b, h) + aoff + m * 2048 + k * 1024); } while (0)
#define PG8_LDB(dst, b, h) do { _Pragma("unroll") for (int n = 0; n < 2; ++n) _Pragma("unroll") for (int k = 0; k < 2; ++k) dst[n][k] = *(const PG8_LAS bf16x8*)(lds + PG8_SB(b, h) + boff + n * 2048 + k * 1024); } while (0)
#define PG8_MMA(ai, bj, At, Bt) do { __builtin_amdgcn_s_setprio(1); _Pragma("unroll") for (int m = 0; m < 4; ++m) _Pragma("unroll") for (int n = 0; n < 2; ++n) _Pragma("unroll") for (int k = 0; k < 2; ++k) \
        acc[ai][bj][m][n] = __builtin_amdgcn_mfma_f32_16x16x32_bf16(Bt[n][k], At[m][k], acc[ai][bj][m][n], 0, 0, 0); __builtin_amdgcn_s_setprio(0); } while (0)
#define PG8_WAIT_V(n) asm volatile("s_waitcnt vmcnt(" #n ")" ::: "memory")
#define PG8_WAIT_L(n) asm volatile("s_waitcnt lgkmcnt(" #n ")" ::: "memory")
#define PG8_BAR __builtin_amdgcn_s_barrier()
#define PG8_SCHED __builtin_amdgcn_sched_barrier(0)
    Unit cur, nxt; int ui = 0;
    if (!S.next(0, cur)) return;
    f32x4 acc[2][2][4][2];
#pragma unroll
    for (int a = 0; a < 2; ++a)
#pragma unroll
        for (int b = 0; b < 2; ++b)
#pragma unroll
            for (int m = 0; m < 4; ++m)
#pragma unroll
                for (int n = 0; n < 2; ++n) acc[a][b][m][n] = (f32x4){0.f, 0.f, 0.f, 0.f};
    bf16x8 At[4][2], B0[2][2], B1[2][2];
    const char* cA = (const char*)g.A + (size_t)cur.pm * tstep; const char* cB = (const char*)g.Bt + (size_t)cur.pn * tstep;
    S.a_ready(cur);
    if constexpr (SP2) {
        PG8_STAGE(PG8_SB(0, 0), cB, voffB); PG8_STAGE(PG8_SB(0, 1), cB + hstep, voffB); PG8_STAGE(PG8_SA(0, 0), cA, voffA); PG8_STAGE(PG8_SA(0, 1), cA + hstep, voffA);
        if (wr == 1) PG8_BAR;
        PG8_WAIT_V(2); PG8_BAR;
        PG8_STAGE(PG8_SB(1, 0), cB + kstep, voffB); PG8_STAGE(PG8_SA(1, 0), cA + kstep, voffA); PG8_STAGE(PG8_SB(1, 1), cB + hstep + kstep, voffB);
        PG8_WAIT_V(6); PG8_BAR;
    } else {
        PG8_STAGE(PG8_SB(0, 0), cB, voffB); PG8_STAGE(PG8_SA(0, 0), cA, voffA); PG8_STAGE(PG8_SB(0, 1), cB + hstep, voffB); PG8_STAGE(PG8_SA(0, 1), cA + hstep, voffA);
        if (wr == 1) PG8_BAR;
        PG8_WAIT_V(4); PG8_BAR;
        PG8_STAGE(PG8_SB(1, 0), cB + kstep, voffB); PG8_STAGE(PG8_SA(1, 0), cA + kstep, voffA); PG8_STAGE(PG8_SB(1, 1), cB + hstep + kstep, voffB);
        PG8_WAIT_V(6); PG8_BAR;
    }
    for (;;) {
        const bool has_next = S.next(ui + 1, nxt);
        const char* nA = has_next ? (const char*)g.A + (size_t)nxt.pm * tstep : cA; const char* nB = has_next ? (const char*)g.Bt + (size_t)nxt.pn * tstep : cB;
        for (int t = 0; t < nt; t += 2) {
            const bool last = (t == nt - 2);
            const char* a1 = cA + (size_t)(t + 1) * kstep;
            const char* a2 = last ? nA : cA + (size_t)(t + 2) * kstep; const char* b2 = last ? nB : cB + (size_t)(t + 2) * kstep;
            const char* a3 = a2 + kstep; const char* b3 = b2 + kstep;
            if (last && has_next) S.a_ready(nxt);
            if constexpr (SP2) {
            PG8_LDB(B0, 0, 0); PG8_LDB(B1, 0, 1); PG8_SCHED; PG8_LDA(At, 0, 0); PG8_STAGE(PG8_SA(1, 1), a1 + hstep, voffA);
            PG8_WAIT_V(8); PG8_WAIT_L(0); PG8_BAR; PG8_MMA(0, 0, At, B0); PG8_MMA(0, 1, At, B1); PG8_BAR; PG8_SCHED;
            PG8_LDA(At, 0, 1); PG8_STAGE(PG8_SB(0, 0), b2, voffB); PG8_STAGE(PG8_SB(0, 1), b2 + hstep, voffB); PG8_STAGE(PG8_SA(0, 0), a2, voffA);
            PG8_WAIT_V(8); PG8_WAIT_L(0); PG8_BAR; PG8_MMA(1, 0, At, B0); PG8_MMA(1, 1, At, B1); PG8_BAR; PG8_SCHED;
            PG8_LDB(B0, 1, 0); PG8_LDB(B1, 1, 1); PG8_SCHED; PG8_LDA(At, 1, 0); PG8_STAGE(PG8_SA(0, 1), a2 + hstep, voffA);
            PG8_WAIT_V(8); PG8_WAIT_L(0); PG8_BAR; PG8_MMA(0, 0, At, B0); PG8_MMA(0, 1, At, B1); PG8_BAR; PG8_SCHED;
            PG8_LDA(At, 1, 1); PG8_STAGE(PG8_SB(1, 0), b3, voffB); PG8_STAGE(PG8_SB(1, 1), b3 + hstep, voffB); PG8_STAGE(PG8_SA(1, 0), a3, voffA);
            PG8_WAIT_V(8); PG8_WAIT_L(0); PG8_BAR; PG8_MMA(1, 0, At, B0); PG8_MMA(1, 1, At, B1); PG8_BAR; PG8_SCHED;
            } else {
            PG8_LDB(B0, 0, 0); PG8_SCHED; PG8_LDA(At, 0, 0); PG8_STAGE(PG8_SA(1, 1), a1 + hstep, voffA);
            PG8_WAIT_L(8); PG8_BAR; PG8_WAIT_L(0); PG8_MMA(0, 0, At, B0); PG8_BAR; PG8_SCHED;
            PG8_LDB(B1, 0, 1); PG8_STAGE(PG8_SB(0, 0), b2, voffB);
            PG8_BAR; PG8_WAIT_L(0); PG8_MMA(0, 1, At, B1); PG8_BAR;
            PG8_LDA(At, 0, 1); PG8_STAGE(PG8_SA(0, 0), a2, voffA);
            PG8_BAR; PG8_WAIT_L(0); PG8_MMA(1, 0, At, B0); PG8_BAR; PG8_SCHED;
            PG8_STAGE(PG8_SB(0, 1), b2 + hstep, voffB);
            PG8_WAIT_V(6); PG8_BAR; PG8_MMA(1, 1, At, B1); PG8_BAR;
            PG8_LDB(B0, 1, 0); PG8_SCHED; PG8_LDA(At, 1, 0); PG8_STAGE(PG8_SA(0, 1), a2 + hstep, voffA);
            PG8_WAIT_L(8); PG8_BAR; PG8_WAIT_L(0); PG8_MMA(0, 0, At, B0); PG8_BAR; PG8_SCHED;
            PG8_LDB(B1, 1, 1); PG8_STAGE(PG8_SB(1, 0), b3, voffB);
            PG8_BAR; PG8_WAIT_L(0); PG8_MMA(0, 1, At, B1); PG8_BAR;
            PG8_LDA(At, 1, 1); PG8_STAGE(PG8_SA(1, 0), a3, voffA);
            PG8_BAR; PG8_WAIT_L(0); PG8_MMA(1, 0, At, B0); PG8_BAR; PG8_SCHED;
            PG8_STAGE(PG8_SB(1, 1), b3 + hstep, voffB);
            PG8_WAIT_V(6); PG8_BAR; PG8_MMA(1, 1, At, B1); PG8_BAR;
            }
        }
        if constexpr (ALIGN_EPI) { if (wr == 0) PG8_BAR; }
        if constexpr (!Epi::AFTER_DRAIN) { E(acc, cur, wr, wc, fr, fq); S.done(cur); }
        if (!has_next) break;
#pragma unroll
        for (int a = 0; a < 2; ++a)
#pragma unroll
            for (int b = 0; b < 2; ++b)
#pragma unroll
                for (int m = 0; m < 4; ++m)
#pragma unroll
                    for (int n = 0; n < 2; ++n) acc[a][b][m][n] = (f32x4){0.f, 0.f, 0.f, 0.f};
        cur = nxt; cA = nA; cB = nB; ++ui;
        if constexpr (ALIGN_EPI) { if (wr == 1) PG8_BAR; }
    }
    PG8_WAIT_V(0);
    if constexpr (!ALIGN_EPI) { if (wr == 0) PG8_BAR; }
    PG8_BAR;
    if constexpr (Epi::AFTER_DRAIN) { E.fused(acc, cur, wr, wc, fr, fq, lds, wid, lane); S.done(cur); }
#undef PG8_SA
#undef PG8_SB
#undef PG8_STAGE
#undef PG8_LDA
#undef PG8_LDB
#undef PG8_MMA
#undef PG8_WAIT_V
#undef PG8_WAIT_L
#undef PG8_BAR
#undef PG8_SCHED
}
}

constexpr int DM = 1024, SEQ = 8192, NB = 2, MP = NB * SEQ, MS = 512, M = MP + MS;
constexpr int NPROJ = 1280, FF = 4096, NG = 32, NP = 64, NC = 16;
constexpr long O_YP = 0, O_YS = 16777216, O_KP = 17301504, O_VP = 17334272, O_SRP = 17367040, O_SIP = 17371136, O_KS = 17375232, O_VS = 19472384, O_SRS = 21569536, O_SIS = 21831680;
constexpr int TCH = 64, NCH = SEQ / TCH;
typedef unsigned short bf16;
typedef float f32x4 __attribute__((ext_vector_type(4)));
typedef unsigned v4u __attribute__((ext_vector_type(4)));
#define LAS __attribute__((address_space(3)))
#define GAS __attribute__((address_space(1)))

constexpr size_t MiB = 1u << 20;
constexpr size_t WS_CTL = 0;
constexpr size_t WS_WIN = 1 * MiB;
constexpr size_t WS_WOUT = 4 * MiB;
constexpr size_t WS_WUP = 6 * MiB;
constexpr size_t WS_WDN = 14 * MiB;
constexpr size_t WS_WGLU = 22 * MiB;
constexpr size_t WS_SSMP = 23 * MiB;
constexpr size_t WS_XN = 24 * MiB;
constexpr size_t WS_QKVU = 58 * MiB;
constexpr size_t WS_MERGED = 100 * MiB;
constexpr size_t WS_H = 58 * MiB;
constexpr size_t WS_OATT = 134 * MiB;
constexpr size_t WS_OSSM = 168 * MiB;
constexpr size_t WS_G = 202 * MiB;
constexpr size_t WS_SLOC = 220 * MiB;
constexpr size_t WS_END = 256 * MiB;

__device__ __forceinline__ unsigned f2bf(float f) { unsigned u = __builtin_bit_cast(unsigned, f); return (u + 0x7fffu + ((u >> 16) & 1u)) >> 16; }
__device__ __forceinline__ unsigned pk2(float lo, float hi) { return f2bf(lo) | (f2bf(hi) << 16); }
__device__ __forceinline__ float bf2f(bf16 b) { return __uint_as_float((unsigned)b << 16); }
__device__ __forceinline__ float wave_sum(float v) {
#pragma unroll
    for (int o = 1; o < 64; o <<= 1) v += __shfl_xor(v, o);
    return v;
}

__device__ __forceinline__ void p0_transpose_item(const float* W, int K, int N, bf16* WT, LAS float* scr, int item, int lane) {
    const int nblk = N / 32, kb = item / nblk, nb = item % nblk, k0 = 64 * kb, n0 = 32 * nb;
#pragma unroll 8
    for (int i = 0; i < 32; ++i) { const int kk = 2 * i + (lane >> 5); scr[kk * 33 + (lane & 31)] = W[(size_t)(k0 + kk) * N + n0 + (lane & 31)]; }
    asm volatile("s_waitcnt lgkmcnt(0)" ::: "memory");
    const int c = lane & 7;
#pragma unroll
    for (int j = 0; j < 4; ++j) { const int n = (lane >> 3) + 8 * j; const LAS float* s = scr + (8 * c) * 33 + n;
        v4u o; o.x = pk2(s[0 * 33], s[1 * 33]); o.y = pk2(s[2 * 33], s[3 * 33]); o.z = pk2(s[4 * 33], s[5 * 33]); o.w = pk2(s[6 * 33], s[7 * 33]);
        *(v4u*)(WT + (size_t)(n0 + n) * K + k0 + 8 * c) = o; }
    asm volatile("s_waitcnt lgkmcnt(0)" ::: "memory");
}
__device__ __forceinline__ void rms_row_to_bf16(const float* xrow, const float* gain, bf16* orow, int lane) {
    const f32x4* xr = (const f32x4*)xrow + lane; const f32x4* gr = (const f32x4*)gain + lane;
    f32x4 v[4]; float s = 0.f;
#pragma unroll
    for (int j = 0; j < 4; ++j) { v[j] = xr[64 * j]; s += (v[j].x * v[j].x + v[j].y * v[j].y) + (v[j].z * v[j].z + v[j].w * v[j].w); }
    const float rstd = 1.f / sqrtf(wave_sum(s) * (1.f / 1024.f) + 1e-6f);
    unsigned long long* o8 = (unsigned long long*)orow + lane;
#pragma unroll
    for (int j = 0; j < 4; ++j) { const f32x4 g = gr[64 * j]; o8[64 * j] = (unsigned long long)pk2(v[j].x * rstd * g.x, v[j].y * rstd * g.y) | ((unsigned long long)pk2(v[j].z * rstd * g.z, v[j].w * rstd * g.w) << 32); }
}

#define XB_TMO      128
#define XB_XCNT(j)  (256  + 64 * (j))
#define XB_XSUB(j)  (1280 + 64 * (j))
#define XB_XGEN(j)  (2304 + 64 * (j))
#define XB_TOP      3328
#define XB_TOPGEN   3392
#define XCD_BAR_WORDS 3456
#define XB_SPIN_CAP (1u << 18)

__device__ __forceinline__ unsigned xb_ld(unsigned* p)              { return __hip_atomic_load(p, __ATOMIC_RELAXED, __HIP_MEMORY_SCOPE_AGENT); }
__device__ __forceinline__ unsigned xb_add(unsigned* p, unsigned v) { return __hip_atomic_fetch_add(p, v, __ATOMIC_RELAXED, __HIP_MEMORY_SCOPE_AGENT); }
__device__ __forceinline__ unsigned xb_xcc_id() { return (unsigned)__builtin_amdgcn_s_getreg((3 << 11) | 20) & 0xFu; }
#define XB_SPIN(cond, bar) do { unsigned _sp = 0; while (cond) { __builtin_amdgcn_s_sleep(1); \
    if ((++_sp & 255u) == 0u) { if (xb_ld(&(bar)[XB_TMO])) break; if (_sp > XB_SPIN_CAP) { atomicAdd(&(bar)[XB_TMO], 1u); break; } } } } while (0)

struct XcdBarrier {
    unsigned* bar; unsigned x;
    volatile LAS unsigned* st;
};

__device__ __forceinline__ XcdBarrier xcd_barrier_post(unsigned* bar, volatile LAS unsigned* st) {
    XcdBarrier b; b.bar = bar; b.x = xb_xcc_id(); b.st = st;
    if (threadIdx.x == 0) (void)xb_add(&bar[XB_XCNT(b.x)], 1u);
    return b;
}
__device__ __forceinline__ void xcd_barrier_complete(unsigned* bar, unsigned x, unsigned& nloc, unsigned& nx) {
    const unsigned G = gridDim.x * gridDim.y * gridDim.z;
    unsigned sum, cnt, mine, sp = 0u;
    for (;;) {
        sum = 0u; cnt = 0u; mine = 0u;
#pragma unroll
        for (unsigned j = 0; j < 16; ++j) { const unsigned c = xb_ld(&bar[XB_XCNT(j)]); sum += c; cnt += (c > 0u) ? 1u : 0u; mine = (j == x) ? c : mine; }
        if (sum == G) break;
        __builtin_amdgcn_s_sleep(1);
        if ((++sp & 255u) == 0u) { if (xb_ld(&bar[XB_TMO])) break; if (sp > XB_SPIN_CAP) { atomicAdd(&bar[XB_TMO], 1u); break; } }
    }
    nloc = mine > 0u ? mine : 1u; nx = cnt > 0u ? cnt : 1u;
}

__device__ __forceinline__ void xcd_barrier(const XcdBarrier& b) {
    asm volatile("s_waitcnt vmcnt(0)" ::: "memory");
    __syncthreads();
    if (threadIdx.x == 0) {
        unsigned* bar = b.bar;
        __builtin_amdgcn_s_waitcnt(0);
        unsigned nloc = b.st[0], nx = b.st[1];
        if (nloc == 0u) { xcd_barrier_complete(bar, b.x, nloc, nx); b.st[0] = nloc; b.st[1] = nx; }
        const unsigned old = xb_add(&bar[XB_XSUB(b.x)], 1u);
        const unsigned gen = old / nloc;
        if (old + 1u == (gen + 1u) * nloc) {
            __builtin_amdgcn_fence(__ATOMIC_RELEASE, "agent");
            asm volatile("s_waitcnt vmcnt(0)" ::: "memory");
            const unsigned og = xb_add(&bar[XB_TOP], 1u);
            const unsigned tg = og / nx;
            if (og + 1u == (tg + 1u) * nx) xb_add(&bar[XB_TOPGEN], 1u);
            else XB_SPIN(xb_ld(&bar[XB_TOPGEN]) == tg, bar);
            __builtin_amdgcn_fence(__ATOMIC_ACQUIRE, "agent");
            xb_add(&bar[XB_XGEN(b.x)], 1u);
            asm volatile("s_waitcnt vmcnt(0)" ::: "memory");
        } else {
            XB_SPIN(xb_ld(&bar[XB_XGEN(b.x)]) == gen, bar);
            __builtin_amdgcn_fence(__ATOMIC_ACQUIRE, "agent");
            asm volatile("s_waitcnt vmcnt(0)" ::: "memory");
        }
    }
    __syncthreads();
}

#ifndef REP_ATT
#define REP_ATT 1
#endif
#ifndef REP_SCAN
#define REP_SCAN 1
#endif
#ifndef REP_P1
#define REP_P1 1
#endif
#ifndef REP_SA
#define REP_SA 1
#endif
#ifndef REP_P3
#define REP_P3 1
#endif
typedef GAS unsigned gu32;
constexpr int CW_BAR = 4096;
constexpr size_t CTL_ZERO_BYTES = 64 * 1024;
constexpr int RING_BYTES = 131072, LDSCTL_OFF = RING_BYTES, MISC_OFF = LDSCTL_OFF + 320, LDS_BYTES = 147456;
struct Args { const float* in[27]; float* out; unsigned char* ws; };

__device__ __forceinline__ int rel_bucket(int n) {
    if (n < 16) return n;
    const int l = 16 + (int)(logf((float)n / 16.f) / logf(8.f) * 16.f);
    return l < 31 ? l : 31;
}
__device__ __forceinline__ float gelu_tanh(float x) { const float u = 0.7978845608028654f * (x + 0.044715f * x * x * x); return 0.5f * x * (1.f + tanhf(u)); }


typedef short bf16x8 __attribute__((ext_vector_type(8)));
typedef float f32x16 __attribute__((ext_vector_type(16)));
typedef unsigned u32x2 __attribute__((ext_vector_type(2)));
constexpr size_t SSM_LB = WS_SSMP;
constexpr size_t SSM_BBT = WS_SSMP + 128 * 1024;
constexpr size_t SSM_CCT = WS_SSMP + 256 * 1024;
constexpr size_t WS_PRE = WS_SLOC;
constexpr size_t WS_TOT = WS_SLOC + 4 * MiB;
__device__ __forceinline__ unsigned cvtpk(float lo, float hi) { unsigned r; asm volatile("v_cvt_pk_bf16_f32 %0, %1, %2" : "=v"(r) : "v"(lo), "v"(hi)); return r; }
struct cplx { float r, i; };
__device__ __forceinline__ cplx cmul(cplx a, cplx b) { return {a.r * b.r - a.i * b.i, a.r * b.i + a.i * b.r}; }
__device__ __forceinline__ cplx cfma(cplx l, cplx h, cplx u) { return {l.r * h.r - l.i * h.i + u.r, l.r * h.i + l.i * h.r + u.i}; }
__device__ __forceinline__ cplx ldc(const float* p) { const float2 v = *(const float2*)p; return {v.x, v.y}; }
__device__ __forceinline__ int tok_of_row(int rho) { return 16 * ((rho >> 2) & 1) + (rho & 3) + 4 * (rho >> 3); }

__device__ __forceinline__ void ssm_bu_tile(f32x16 (&acc)[4], const bf16* urow_base  , const bf16x8 (&bfr)[4], int lane) {
    const int rho = lane & 31, h = lane >> 5;
    const bf16x8 a = *(const bf16x8*)(urow_base + (size_t)tok_of_row(rho) * NPROJ + 8 * h);
#pragma unroll
    for (int ct = 0; ct < 4; ++ct) { f32x16 z = {}; acc[ct] = __builtin_amdgcn_mfma_f32_32x32x16_bf16(a, bfr[ct], z, 0, 0, 0); }
}

__device__ __forceinline__ void phase_ssm_pass1(const Args& a, int lane, int wave, int bx, int G) {
    const bf16* QKVU = (const bf16*)(a.ws + WS_QKVU); const float* LB = (const float*)(a.ws + SSM_LB); const bf16* BBT = (const bf16*)(a.ws + SSM_BBT);
    float* PRE = (float*)(a.ws + WS_PRE); float* TOT = (float*)(a.ws + WS_TOT);
    const int c32 = lane & 31, hi = lane >> 5;
    for (int it = wave * G + bx; it < NB * 16 * NG; it += 8 * G) {
        const int g = it & 31, k = (it >> 5) & 15, b = it >> 9;
        bf16x8 bfr[4];
#pragma unroll
        for (int ct = 0; ct < 4; ++ct) bfr[ct] = *(const bf16x8*)(BBT + ((size_t)(g * 2 + (ct >> 1)) * NP + 32 * (ct & 1) + c32) * NC + 8 * hi);
        cplx l1[2], wA[2], wB[2], l64[2], R[2];
#pragma unroll
        for (int ph = 0; ph < 2; ++ph) { const int gp = g * NP + 32 * ph + c32;
            l1[ph] = ldc(LB + gp * 2); l64[ph] = ldc(LB + (4 * 2048 + gp) * 2);
            wA[ph] = ldc(LB + ((hi ? 2 : 3) * 2048 + gp) * 2);
            wB[ph] = hi ? cplx{1.f, 0.f} : ldc(LB + (1 * 2048 + gp) * 2);
            R[ph] = {0.f, 0.f}; }
        for (int i = 0; i < 8; ++i) {
            const int j = 8 * k + i; const size_t row0 = (size_t)b * SEQ + j * TCH;
            if (hi == 0) {
#pragma unroll
                for (int ph = 0; ph < 2; ++ph) *(float2*)(PRE + ((size_t)((b * NCH + j) * NG + g) * NP + 32 * ph + c32) * 2) = make_float2(R[ph].r, R[ph].i); }
            cplx e[2][2];
#pragma unroll
            for (int T = 0; T < 2; ++T) {
                f32x16 acc[4]; ssm_bu_tile(acc, QKVU + (row0 + 32 * T) * NPROJ + 768 + g * NC, bfr, lane);
#pragma unroll
                for (int ph = 0; ph < 2; ++ph) { cplx h = {0.f, 0.f};
#pragma unroll
                    for (int r = 0; r < 16; ++r) h = cfma(l1[ph], h, cplx{acc[ph][r], acc[2 + ph][r]});
                    e[T][ph] = h; }
            }
#pragma unroll
            for (int ph = 0; ph < 2; ++ph) { cplx v = cmul(wA[ph], e[0][ph]); v = cfma(wB[ph], e[1][ph], v);
                v.r += __shfl_xor(v.r, 32); v.i += __shfl_xor(v.i, 32);
                R[ph] = cfma(l64[ph], R[ph], v); }
        }
        if (hi == 0) {
#pragma unroll
            for (int ph = 0; ph < 2; ++ph) *(float2*)(TOT + ((size_t)((b * 16 + k) * NG + g) * NP + 32 * ph + c32) * 2) = make_float2(R[ph].r, R[ph].i); }
    }
}

constexpr int GS_OFF = 0, HS_OFF = 65536;
__device__ __forceinline__ int gs_addr(int t, int ch) { return GS_OFF + t * 1024 + ((((ch >> 3) ^ (t & 15))) << 4) + (ch & 7) * 2; }
__device__ __forceinline__ float gelu_fast(float x) { const float u2 = 1.5957691216057308f * (x + 0.044715f * x * x * x); return x * __builtin_amdgcn_rcpf(1.f + __expf(-u2)); }
struct GTab { bf16x8 bfr[4]; bf16x8 a0; cplx l1[2]; };
__device__ __forceinline__ void ssm_load_gtab(GTab& t, const bf16* BBT, const float* LB, const bf16* QKVU, size_t row0, int g, int c32, int hi) {
#pragma unroll
    for (int ct = 0; ct < 4; ++ct) t.bfr[ct] = *(const bf16x8*)(BBT + ((size_t)(g * 2 + (ct >> 1)) * NP + 32 * (ct & 1) + c32) * NC + 8 * hi);
#pragma unroll
    for (int ph = 0; ph < 2; ++ph) t.l1[ph] = ldc(LB + (g * NP + 32 * ph + c32) * 2);
    t.a0 = *(const bf16x8*)(QKVU + (row0 + tok_of_row(c32)) * NPROJ + 768 + g * NC + 8 * hi);
}
template <bool SAMPLE> __device__ __forceinline__ void ssm_unit_scan(const Args& a, LAS unsigned char* L, int lane, int wave, int unit) {
    const bf16* QKVU = (const bf16*)(a.ws + WS_QKVU); const float* LB = (const float*)(a.ws + SSM_LB); const bf16* BBT = (const bf16*)(a.ws + SSM_BBT); const bf16* CCT = (const bf16*)(a.ws + SSM_CCT);
    const float* PRE = (const float*)(a.ws + WS_PRE); const float* TOT = (const float*)(a.ws + WS_TOT);
    const int c32 = lane & 31, hi = lane >> 5, fr = lane & 15, fq = lane >> 4;
    const int b = unit >> 7, j = unit & 127;
    const size_t row0 = SAMPLE ? (size_t)MP + 64 * unit : (size_t)b * SEQ + j * TCH;
    LAS unsigned char* Hs = L + HS_OFF + wave * 8192;
    GTab cur; ssm_load_gtab(cur, BBT, LB, QKVU, row0, wave * 4, c32, hi);
    typedef float f32x2v __attribute__((ext_vector_type(2)));
    LAS f32x2v* CIN = (LAS f32x2v*)(L + 132096) + wave * 192;
    cplx cin0 = {0.f, 0.f};
    if (!SAMPLE) {
        const int k = j >> 3, i = j & 7;
#pragma unroll
        for (int gb = 0; gb < 4; gb += 2) {
            cplx tt[2][15], pre[2], l512[2], l64[2];
#pragma unroll
            for (int gi = 0; gi < 2; ++gi) { const int g = wave * 4 + gb + gi, gp = g * NP + lane;
                l512[gi] = ldc(LB + (5 * 2048 + gp) * 2); l64[gi] = ldc(LB + (4 * 2048 + gp) * 2); pre[gi] = ldc(PRE + ((size_t)((b * NCH + j) * NG + g) * NP + lane) * 2);
#pragma unroll
                for (int kk = 0; kk < 15; ++kk) tt[gi][kk] = ldc(TOT + ((size_t)((b * 16 + kk) * NG + g) * NP + lane) * 2); }
#pragma unroll
            for (int gi = 0; gi < 2; ++gi) { cplx E = {0.f, 0.f};
#pragma unroll
                for (int kk = 0; kk < 15; ++kk) { const cplx n = cfma(l512[gi], E, tt[gi][kk]); E.r = kk < k ? n.r : E.r; E.i = kk < k ? n.i : E.i; }
                cplx w = {1.f, 0.f};
#pragma unroll
                for (int q = 0; q < 7; ++q) { const cplx n = cmul(w, l64[gi]); w.r = q < i ? n.r : w.r; w.i = q < i ? n.i : w.i; }
                const cplx c = cfma(w, E, pre[gi]); if (gb + gi == 0) cin0 = c; else CIN[(gb + gi - 1) * 64 + lane] = (f32x2v){c.r, c.i}; }
        }
    }
#pragma unroll 1
    for (int gi = 0; gi < 4; ++gi) {
        const int g = wave * 4 + gi;
        GTab nxt; ssm_load_gtab(nxt, BBT, LB, QKVU, row0, g + 1 < NG ? g + 1 : g, c32, hi);
        cplx h[2];
        if (!SAMPLE) {
            if (gi == 0) {
#pragma unroll
                for (int ph = 0; ph < 2; ++ph) { h[ph].r = __shfl(cin0.r, 32 * ph + c32); h[ph].i = __shfl(cin0.i, 32 * ph + c32); } }
            else {
#pragma unroll
                for (int ph = 0; ph < 2; ++ph) { const f32x2v c = CIN[(gi - 1) * 64 + 32 * ph + c32]; h[ph].r = c.x; h[ph].i = c.y; } } }
        bf16x8 cfr[4];
#pragma unroll
        for (int ks = 0; ks < 4; ++ks) cfr[ks] = *(const bf16x8*)(CCT + ((size_t)(g * NC + fr)) * 128 + 32 * ks + 8 * fq);
        const float dv = a.in[17][g * NC + fr];
        bf16x8 a1 = *(const bf16x8*)(QKVU + (row0 + 32 + tok_of_row(c32)) * NPROJ + 768 + g * NC + 8 * hi);
#pragma unroll 1
        for (int T = 0; T < 2; ++T) {
            bf16 uv[8];
#pragma unroll
            for (int e = 0; e < 8; ++e) uv[e] = QKVU[(row0 + 32 * T + 16 * (e >> 2) + 4 * fq + (e & 3)) * NPROJ + 768 + g * NC + fr];
            f32x16 acc[4];
            { const bf16x8 af = T ? a1 : cur.a0;
#pragma unroll
              for (int ct = 0; ct < 4; ++ct) { f32x16 z = {}; acc[ct] = __builtin_amdgcn_mfma_f32_32x32x16_bf16(af, cur.bfr[ct], z, 0, 0, 0); } }
            if (!SAMPLE) {
#pragma unroll
                for (int half = 0; half < 2; ++half) {
                    if (hi == half) {
#pragma unroll
                        for (int ph = 0; ph < 2; ++ph)
#pragma unroll
                            for (int r = 0; r < 16; ++r) { h[ph] = cfma(cur.l1[ph], h[ph], cplx{acc[ph][r], acc[2 + ph][r]}); acc[ph][r] = h[ph].r; acc[2 + ph][r] = h[ph].i; }
                    }
#pragma unroll
                    for (int ph = 0; ph < 2; ++ph) { const float xr = __shfl_xor(h[ph].r, 32), xi = __shfl_xor(h[ph].i, 32); if (hi != half) { h[ph].r = xr; h[ph].i = xi; } }
                }
            } else {
                float h0r[2][4], h0i[2][4];
#pragma unroll
                for (int ph = 0; ph < 2; ++ph)
#pragma unroll
                    for (int q = 0; q < 4; ++q) { const size_t so = (size_t)((unit * 16 + 8 * T + 4 * hi + q) * NG + g) * NP + 32 * ph + c32; h0r[ph][q] = a.in[4][so]; h0i[ph][q] = a.in[5][so]; }
#pragma unroll
                for (int ph = 0; ph < 2; ++ph)
#pragma unroll
                    for (int r = 0; r < 16; ++r) {
                        if ((r & 3) == 0) { h[ph].r = h0r[ph][r >> 2]; h[ph].i = h0i[ph][r >> 2]; }
                        h[ph] = cfma(cur.l1[ph], h[ph], cplx{acc[ph][r], acc[2 + ph][r]}); acc[ph][r] = h[ph].r; acc[2 + ph][r] = h[ph].i;
                        if ((r & 3) == 3) { h0r[ph][r >> 2] = h[ph].r; h0i[ph][r >> 2] = h[ph].i; }
                    }
#pragma unroll
                for (int ph = 0; ph < 2; ++ph)
#pragma unroll
                    for (int q = 0; q < 4; ++q) { const size_t so = (size_t)((unit * 16 + 8 * T + 4 * hi + q) * NG + g) * NP + 32 * ph + c32; a.out[O_SRS + so] = h0r[ph][q]; a.out[O_SIS + so] = h0i[ph][q]; }
            }
            asm volatile("s_waitcnt lgkmcnt(0)" ::: "memory");
#pragma unroll
            for (int ph = 0; ph < 2; ++ph)
#pragma unroll
                for (int r = 0; r < 16; ++r) { const int tl = 16 * hi + r, p = 32 * ph + c32;
                    *(LAS unsigned*)(Hs + tl * 256 + (((p >> 2) ^ (tl & 15)) << 4) + (p & 3) * 4) = cvtpk(acc[ph][r], acc[2 + ph][r]); }
            asm volatile("s_waitcnt lgkmcnt(0)" ::: "memory");
#pragma unroll
            for (int mt = 0; mt < 2; ++mt) {
                f32x4 y = {0.f, 0.f, 0.f, 0.f};
#pragma unroll
                for (int ks = 0; ks < 4; ++ks) { const int tl = 16 * mt + fr;
                    const bf16x8 af = *(const LAS bf16x8*)(Hs + tl * 256 + (((4 * ks + fq) ^ (tl & 15)) << 4));
                    y = __builtin_amdgcn_mfma_f32_16x16x32_bf16(af, cfr[ks], y, 0, 0, 0); }
#pragma unroll
                for (int i = 0; i < 4; ++i) { const int t = 32 * T + 16 * mt + 4 * fq + i;
                    *(LAS bf16*)(L + gs_addr(t, g * NC + fr)) = (bf16)f2bf(gelu_fast(y[i] + dv * bf2f(uv[4 * mt + i]))); }
            }
        }
        if (!SAMPLE && j == NCH - 1 && hi == 1) {
#pragma unroll
            for (int ph = 0; ph < 2; ++ph) { const size_t so = (size_t)(b * NG + g) * NP + 32 * ph + c32; a.out[O_SRP + so] = h[ph].r; a.out[O_SIP + so] = h[ph].i; }
        }
        cur = nxt;
    }
}
__device__ __forceinline__ void ssm_unit_glu(const Args& a, LAS unsigned char* L, int tid, int lane, int wave, size_t row0) {
    const bf16* WG = (const bf16*)(a.ws + WS_WGLU);
    bf16* MG = (bf16*)(a.ws + WS_MERGED);
    const int c32 = lane & 31, hi = lane >> 5;
    f32x16 acc[2][2];
#pragma unroll
    for (int nt = 0; nt < 2; ++nt)
#pragma unroll
        for (int tt = 0; tt < 2; ++tt) acc[nt][tt] = f32x16{};
    LAS unsigned char* WS = L + HS_OFF + wave * 8192;
    const bf16* wsrc = WG + (size_t)(64 * wave + (lane >> 3)) * 512 + 8 * (lane & 7);
    v4u wr[8];
#pragma unroll
    for (int i = 0; i < 8; ++i) wr[i] = *(const v4u*)(wsrc + (size_t)(8 * i) * 512);
#pragma unroll 1
    for (int kb = 0; kb < 8; ++kb) {
        asm volatile("s_waitcnt lgkmcnt(0)" ::: "memory");
#pragma unroll
        for (int i = 0; i < 8; ++i) { const int n = (lane >> 3) + 8 * i; *(LAS v4u*)(WS + n * 128 + (((lane & 7) ^ ((n >> 1) & 7)) << 4)) = wr[i]; }
        if (kb < 7) {
#pragma unroll
            for (int i = 0; i < 8; ++i) wr[i] = *(const v4u*)(wsrc + (size_t)(8 * i) * 512 + 64 * (kb + 1)); }
        asm volatile("s_waitcnt lgkmcnt(0)" ::: "memory");
#pragma unroll
        for (int s4 = 0; s4 < 4; ++s4) {
            bf16x8 gb[2], wa[2];
#pragma unroll
            for (int tt = 0; tt < 2; ++tt) { const int t = 32 * tt + c32; gb[tt] = *(const LAS bf16x8*)(L + GS_OFF + t * 1024 + (((8 * kb + 4 * hi + s4) ^ (t & 15)) << 4)); }
#pragma unroll
            for (int nt = 0; nt < 2; ++nt) { const int n = 32 * nt + c32; wa[nt] = *(const LAS bf16x8*)(WS + n * 128 + (((4 * hi + s4) ^ ((n >> 1) & 7)) << 4)); }
#pragma unroll
            for (int nt = 0; nt < 2; ++nt)
#pragma unroll
                for (int tt = 0; tt < 2; ++tt) acc[nt][tt] = __builtin_amdgcn_mfma_f32_32x32x16_bf16(wa[nt], gb[tt], acc[nt][tt], 0, 0, 0);
        }
    }
    __syncthreads();
    float ssq[2] = {0.f, 0.f};
#pragma unroll
    for (int nt = 0; nt < 2; ++nt)
#pragma unroll
        for (int q4 = 0; q4 < 4; ++q4) { const int n0 = 64 * wave + 32 * nt + 8 * q4 + 4 * hi; const f32x4 bv = *(const f32x4*)(a.in[19] + n0);
#pragma unroll
            for (int tt = 0; tt < 2; ++tt) { const int t = 32 * tt + c32; LAS u32x2* gp = (LAS u32x2*)(L + gs_addr(t, n0)); const u32x2 gw = *gp;
                float o[4];
#pragma unroll
                for (int e = 0; e < 4; ++e) { const float gv = __uint_as_float(((e & 1) ? (gw[e >> 1] & 0xffff0000u) : (gw[e >> 1] << 16))); const float z = acc[nt][tt][4 * q4 + e] + bv[e];
                    o[e] = gv * __builtin_amdgcn_rcpf(1.f + __expf(-z)); ssq[tt] += o[e] * o[e]; }
                u32x2 ow; ow[0] = cvtpk(o[0], o[1]); ow[1] = cvtpk(o[2], o[3]); *gp = ow; }
        }
    LAS float* SS = (LAS float*)(L + HS_OFF);
#pragma unroll
    for (int tt = 0; tt < 2; ++tt) { const float s = ssq[tt] + __shfl_xor(ssq[tt], 32); if (hi == 0) SS[wave * 64 + 32 * tt + c32] = s; }
    __syncthreads();
    {
        const int t = tid >> 3, part = tid & 7; float s = 0.f;
#pragma unroll
        for (int w = 0; w < 8; ++w) s += SS[w * 64 + t];
        const float rstd = 1.f / sqrtf(s * (1.f / 512.f) + 1e-6f);
        bf16* dst = MG + (row0 + t) * 1024 + 512 + 64 * part; const float* gn = a.in[21] + 64 * part;
#pragma unroll
        for (int c = 0; c < 8; ++c) { const v4u v = *(const LAS v4u*)(L + GS_OFF + t * 1024 + (((8 * part + c) ^ (t & 15)) << 4)); const f32x4 g0 = *(const f32x4*)(gn + 8 * c), g1 = *(const f32x4*)(gn + 8 * c + 4);
            v4u o; o.x = cvtpk(__uint_as_float(v.x << 16) * rstd * g0.x, __uint_as_float(v.x & 0xffff0000u) * rstd * g0.y); o.y = cvtpk(__uint_as_float(v.y << 16) * rstd * g0.z, __uint_as_float(v.y & 0xffff0000u) * rstd * g0.w);
            o.z = cvtpk(__uint_as_float(v.z << 16) * rstd * g1.x, __uint_as_float(v.z & 0xffff0000u) * rstd * g1.y); o.w = cvtpk(__uint_as_float(v.w << 16) * rstd * g1.z, __uint_as_float(v.w & 0xffff0000u) * rstd * g1.w);
            *(v4u*)(dst + 8 * c) = o; }
    }
    __syncthreads();
}
__device__ __forceinline__ void phase_ssm_pass2(const Args& a, LAS unsigned char* L, int tid0, int wave, int bx, int G) {
    for (int u = bx; u < 256 + 8; u += G) {
        int tid = tid0; asm volatile("" : "+v"(tid));
        const int lane = tid & 63;
        if (u < 256) { _Pragma("unroll 1") for (int rep = 0; rep < REP_SCAN; ++rep) { int t3 = tid; asm volatile("" : "+v"(t3)); ssm_unit_scan<false>(a, L, t3 & 63, wave, u); } __syncthreads(); int t2 = tid; asm volatile("" : "+v"(t2)); ssm_unit_glu(a, L, t2, t2 & 63, wave, (size_t)(u >> 7) * SEQ + (u & 127) * TCH); }
        else { ssm_unit_scan<true>(a, L, lane, wave, u - 256); __syncthreads(); int t2 = tid; asm volatile("" : "+v"(t2)); ssm_unit_glu(a, L, t2, t2 & 63, wave, (size_t)MP + 64 * (u - 256)); }
    }
}

typedef short v4i16_t __attribute__((ext_vector_type(4)));
constexpr float LOG2E = 1.4426950408889634f;
constexpr int AK_OFF = 0, AV_OFF = 24576, AO_OFF = 49152, ABT_OFF = 114688, ALI_OFF = ABT_OFF + 8 * 192 * 4;
__device__ __forceinline__ int crow(int r, int hi) { return (r & 3) + 8 * (r >> 2) + 4 * hi; }
__device__ __forceinline__ void attn_build_table(const Args& a, LAS unsigned char* L, int tid) {
    LAS float* BT = (LAS float*)(L + ABT_OFF);
    for (int e = tid; e < 8 * 192; e += 512) { const int h = e / 192, dist = e % 192 - 32; BT[e] = (dist >= 0 && dist < 128) ? a.in[6][rel_bucket(dist) * 8 + h] * LOG2E : -1e30f; }
}
__device__ __forceinline__ void attn_unit(const Args& a, LAS unsigned char* L, int tid, int lane, int wave, int unit) {
    const bf16* QKVU = (const bf16*)(a.ws + WS_QKVU); bf16* MG = (bf16*)(a.ws + WS_MERGED);
    const int qh = unit & 1, n = (unit >> 1) & 63, b = unit >> 7;
    const int c32 = lane & 31, hi = lane >> 5;
    const int rh = wave >> 1, qg = 2 * qh + (wave & 1);
    const size_t qrow = (size_t)b * SEQ + n * 128 + 32 * qg + c32;
    const size_t blk0 = (size_t)b * SEQ + (size_t)(n - 1) * 128;
    LAS const float* BT = (LAS const float*)(L + ABT_OFF);
    LAS float* LI = (LAS float*)(L + ALI_OFF) + wave * 32;
    for (int g = 0; g < 2; ++g) {
        for (int pc = wave * 6; pc < wave * 6 + 6; ++pc) {
            if (pc < 24) { const int lt = pc >> 2, cp = pc & 3, chunk = 2 * cp + (lane >> 5), key = lane & 31; int j = 64 * qh + 32 * lt + key; if (n == 0 && j < 128) j += 128;
                const v4u v = *(const v4u*)(QKVU + (blk0 + j) * NPROJ + 512 + g * 64 + chunk * 8);
                *(LAS v4u*)(L + AK_OFF + lt * 4096 + cp * 1024 + lane * 16) = v; }
            else { const int q = pc - 24, lt = q >> 2, dh = (q >> 1) & 1, ks = q & 1, key = lane >> 2, c4 = lane & 3; int j = 64 * qh + 32 * lt + 16 * ks + key; if (n == 0 && j < 128) j += 128;
                const v4u v = *(const v4u*)(QKVU + (blk0 + j) * NPROJ + 640 + g * 64 + dh * 32 + c4 * 8);
                *(LAS v4u*)(L + AV_OFF + lt * 4096 + dh * 2048 + ks * 1024 + lane * 16) = v; }
        }
        const int h = 4 * g + rh;
        bf16x8 qf[4];
#pragma unroll
        for (int d0 = 0; d0 < 4; ++d0) qf[d0] = *(const bf16x8*)(QKVU + qrow * NPROJ + h * 64 + 16 * d0 + 8 * hi);
        __syncthreads();
        f32x16 S[5];
#pragma unroll
        for (int tl = 0; tl < 5; ++tl) { S[tl] = f32x16{};
            LAS const unsigned char* Kt = L + AK_OFF + ((wave & 1) + tl) * 4096 + hi * 512 + c32 * 16;
#pragma unroll
            for (int d0 = 0; d0 < 4; ++d0) S[tl] = __builtin_amdgcn_mfma_f32_32x32x16_bf16(*(LAS const bf16x8*)(Kt + d0 * 1024), qf[d0], S[tl], 0, 0, 0); }
        const float sink2 = a.in[9][h] * LOG2E; float m = sink2;
#pragma unroll
        for (int tl = 0; tl < 5; ++tl) { const bool dead = (n == 0) && (qg + tl < 4);
#pragma unroll
            for (int r = 0; r < 16; ++r) { const int x = c32 + 160 - 32 * tl - crow(r, hi);
                const float s = dead ? -1e30f : S[tl][r] * (0.125f * LOG2E) + BT[h * 192 + x]; S[tl][r] = s; m = fmaxf(m, s); } }
        m = fmaxf(m, __shfl_xor(m, 32));
        float l = 0.f;
#pragma unroll
        for (int tl = 0; tl < 5; ++tl)
#pragma unroll
            for (int r = 0; r < 16; ++r) { const float p = __builtin_amdgcn_exp2f(S[tl][r] - m); S[tl][r] = p; l += p; }
        l += __shfl_xor(l, 32); l += __builtin_amdgcn_exp2f(sink2 - m);
        if (hi == 0) LI[c32] = 1.f / l;
        f32x16 o[2]; o[0] = f32x16{}; o[1] = f32x16{};
        const int vb = ((lane >> 4) & 1) * 32 + (lane & 3) * 8 + (4 * hi + ((lane & 15) >> 2)) * 64;
#pragma unroll
        for (int tl = 0; tl < 5; ++tl) { LAS const unsigned char* Vt = L + AV_OFF + ((wave & 1) + tl) * 4096 + vb;
#pragma unroll
            for (int ks = 0; ks < 2; ++ks) {
                v4u pw; pw.x = cvtpk(S[tl][8 * ks + 0], S[tl][8 * ks + 1]); pw.y = cvtpk(S[tl][8 * ks + 2], S[tl][8 * ks + 3]); pw.z = cvtpk(S[tl][8 * ks + 4], S[tl][8 * ks + 5]); pw.w = cvtpk(S[tl][8 * ks + 6], S[tl][8 * ks + 7]);
                const bf16x8 pa = __builtin_bit_cast(bf16x8, pw);
#pragma unroll
                for (int d0 = 0; d0 < 2; ++d0) {
                    const v4i16_t lo = __builtin_amdgcn_ds_read_tr16_b64_v4i16((LAS v4i16_t*)(Vt + d0 * 2048 + ks * 1024));
                    const v4i16_t hv = __builtin_amdgcn_ds_read_tr16_b64_v4i16((LAS v4i16_t*)(Vt + d0 * 2048 + ks * 1024 + 512));
                    const bf16x8 vf = {lo[0], lo[1], lo[2], lo[3], hv[0], hv[1], hv[2], hv[3]};
                    o[d0] = __builtin_amdgcn_mfma_f32_32x32x16_bf16(pa, vf, o[d0], 0, 0, 0); } } }
        asm volatile("s_waitcnt lgkmcnt(0)" ::: "memory");
#pragma unroll
        for (int r = 0; r < 16; ++r) { const int q = crow(r, hi); const float li = LI[q];
#pragma unroll
            for (int d0 = 0; d0 < 2; ++d0) *(LAS bf16*)(L + AO_OFF + (32 * (wave & 1) + q) * 1024 + (h * 64 + 32 * d0 + c32) * 2) = (bf16)f2bf(o[d0][r] * li); }
        __syncthreads();
    }
    {
        const int t = tid >> 3, part = tid & 7; v4u v[8]; float s = 0.f;
#pragma unroll
        for (int c = 0; c < 8; ++c) { v[c] = *(LAS const v4u*)(L + AO_OFF + t * 1024 + part * 128 + ((c + part) & 7) * 16);
#pragma unroll
            for (int e = 0; e < 4; ++e) { const float x0 = __uint_as_float(v[c][e] << 16), x1 = __uint_as_float(v[c][e] & 0xffff0000u); s += x0 * x0 + x1 * x1; } }
        s += __shfl_xor(s, 1); s += __shfl_xor(s, 2); s += __shfl_xor(s, 4);
        const float rstd = 1.f / sqrtf(s * (1.f / 512.f) + 1e-6f);
        bf16* dst = MG + ((size_t)b * SEQ + n * 128 + 64 * qh + t) * 1024 + 64 * part; const float* gn = a.in[20] + 64 * part;
#pragma unroll
        for (int c = 0; c < 8; ++c) { const int cc = (c + part) & 7; const f32x4 g0 = *(const f32x4*)(gn + 8 * cc), g1 = *(const f32x4*)(gn + 8 * cc + 4); const v4u x = v[c];
            v4u w; w.x = cvtpk(__uint_as_float(x.x << 16) * rstd * g0.x, __uint_as_float(x.x & 0xffff0000u) * rstd * g0.y); w.y = cvtpk(__uint_as_float(x.y << 16) * rstd * g0.z, __uint_as_float(x.y & 0xffff0000u) * rstd * g0.w);
            w.z = cvtpk(__uint_as_float(x.z << 16) * rstd * g1.x, __uint_as_float(x.z & 0xffff0000u) * rstd * g1.y); w.w = cvtpk(__uint_as_float(x.w << 16) * rstd * g1.z, __uint_as_float(x.w & 0xffff0000u) * rstd * g1.w);
            *(v4u*)(dst + 8 * cc) = w; }
    }
    __syncthreads();
}
__device__ __forceinline__ void attn_sample_wg(const Args& a, LAS unsigned char* L, int lane, int wave, int s) {
    const bf16* QKVU = (const bf16*)(a.ws + WS_QKVU); bf16* MG = (bf16*)(a.ws + WS_MERGED);
    LAS const float* BT = (LAS const float*)(L + ABT_OFF);
    LAS float* Qs = (LAS float*)(L + wave * 4096); LAS float* Ps = Qs + 256; LAS float* Inv = Ps + 132 * 4; LAS float* SSx = (LAS float*)(L + 32768);
    const int g = wave >> 2, ti = wave & 3; const size_t row0 = (size_t)MP + s * 4;
    f32x4 kf0[16], kf1[16];
    { const f32x4* k0 = (const f32x4*)(a.in[2] + ((size_t)(s * 128 + lane) * 2 + g) * 64); const f32x4* k1 = (const f32x4*)(a.in[2] + ((size_t)(s * 128 + lane + 64) * 2 + g) * 64);
#pragma unroll
      for (int c = 0; c < 16; ++c) { kf0[c] = k0[c]; kf1[c] = k1[c]; } }
    {
        const int r = lane >> 4, dq = lane & 15; const unsigned long long w = *(const unsigned long long*)(QKVU + (row0 + ti) * NPROJ + (4 * g + r) * 64 + 4 * dq); f32x4 q;
        q.x = __uint_as_float((unsigned)w << 16); q.y = __uint_as_float((unsigned)w & 0xffff0000u); q.z = __uint_as_float((unsigned)(w >> 32) << 16); q.w = __uint_as_float((unsigned)(w >> 32) & 0xffff0000u);
        *(LAS f32x4*)(Qs + r * 64 + 4 * dq) = q * (0.125f * LOG2E); }
    asm volatile("s_waitcnt lgkmcnt(0)" ::: "memory");
#pragma unroll
    for (int r = 0; r < 4; ++r) { float d0 = 0.f, d1 = 0.f;
#pragma unroll
        for (int c = 0; c < 16; ++c) { const f32x4 q = *(LAS const f32x4*)(Qs + r * 64 + 4 * c);
            d0 += (q.x * kf0[c].x + q.y * kf0[c].y) + (q.z * kf0[c].z + q.w * kf0[c].w); d1 += (q.x * kf1[c].x + q.y * kf1[c].y) + (q.z * kf1[c].z + q.w * kf1[c].w); }
        Ps[lane * 4 + r] = d0 + BT[(4 * g + r) * 192 + ti + 160 - lane]; Ps[(lane + 64) * 4 + r] = d1 + BT[(4 * g + r) * 192 + ti + 160 - (lane + 64)]; }
    {
        const int jn = lane >> 4, r = (lane >> 2) & 3, dq = lane & 3; const bf16* kp = QKVU + (row0 + jn) * NPROJ + 512 + g * 64 + 16 * dq; float d = 0.f;
#pragma unroll
        for (int c = 0; c < 2; ++c) { const v4u v = *(const v4u*)(kp + 8 * c); const f32x4 q0 = *(LAS const f32x4*)(Qs + r * 64 + 16 * dq + 8 * c), q1 = *(LAS const f32x4*)(Qs + r * 64 + 16 * dq + 8 * c + 4);
            d += q0.x * __uint_as_float(v.x << 16) + q0.y * __uint_as_float(v.x & 0xffff0000u) + q0.z * __uint_as_float(v.y << 16) + q0.w * __uint_as_float(v.y & 0xffff0000u)
               + q1.x * __uint_as_float(v.z << 16) + q1.y * __uint_as_float(v.z & 0xffff0000u) + q1.z * __uint_as_float(v.w << 16) + q1.w * __uint_as_float(v.w & 0xffff0000u); }
        d += __shfl_xor(d, 1); d += __shfl_xor(d, 2);
        if (dq == 0) Ps[(128 + jn) * 4 + r] = d + BT[(4 * g + r) * 192 + ti + 160 - (128 + jn)]; }
    asm volatile("s_waitcnt lgkmcnt(0)" ::: "memory");
    {
        const int r = lane >> 4, part = lane & 15; const float sink2 = a.in[9][4 * g + r] * LOG2E; float m = sink2;
        for (int jj = part; jj < 132; jj += 16) m = fmaxf(m, Ps[jj * 4 + r]);
        m = fmaxf(m, __shfl_xor(m, 1)); m = fmaxf(m, __shfl_xor(m, 2)); m = fmaxf(m, __shfl_xor(m, 4)); m = fmaxf(m, __shfl_xor(m, 8));
        float l = 0.f;
        for (int jj = part; jj < 132; jj += 16) { const float p = __builtin_amdgcn_exp2f(Ps[jj * 4 + r] - m); Ps[jj * 4 + r] = p; l += p; }
        l += __shfl_xor(l, 1); l += __shfl_xor(l, 2); l += __shfl_xor(l, 4); l += __shfl_xor(l, 8); l += __builtin_amdgcn_exp2f(sink2 - m);
        if (part == 0) Inv[r] = 1.f / l; }
    asm volatile("s_waitcnt lgkmcnt(0)" ::: "memory");
    const int d4 = lane & 15, jq = lane >> 4;
    f32x4 acc[4]; acc[0] = acc[1] = acc[2] = acc[3] = (f32x4){0.f, 0.f, 0.f, 0.f};
#pragma unroll
    for (int nb = 0; nb < 32; nb += 16) { f32x4 vv[16];
#pragma unroll
        for (int n = 0; n < 16; ++n) vv[n] = *(const f32x4*)(a.in[3] + ((size_t)(s * 128 + 4 * (nb + n) + jq) * 2 + g) * 64 + 4 * d4);
#pragma unroll
        for (int n = 0; n < 16; ++n) { const f32x4 p = *(LAS const f32x4*)(Ps + (4 * (nb + n) + jq) * 4);
            acc[0] += p.x * vv[n]; acc[1] += p.y * vv[n]; acc[2] += p.z * vv[n]; acc[3] += p.w * vv[n]; } }
    { const unsigned long long w = *(const unsigned long long*)(QKVU + (row0 + jq) * NPROJ + 640 + g * 64 + 4 * d4); f32x4 v;
      v.x = __uint_as_float((unsigned)w << 16); v.y = __uint_as_float((unsigned)w & 0xffff0000u); v.z = __uint_as_float((unsigned)(w >> 32) << 16); v.w = __uint_as_float((unsigned)(w >> 32) & 0xffff0000u);
      const f32x4 p = *(LAS const f32x4*)(Ps + (128 + jq) * 4);
      acc[0] += p.x * v; acc[1] += p.y * v; acc[2] += p.z * v; acc[3] += p.w * v; }
    const f32x4 inv = *(LAS const f32x4*)Inv; float ss = 0.f;
#pragma unroll
    for (int r = 0; r < 4; ++r)
#pragma unroll
        for (int e = 0; e < 4; ++e) { float o = acc[r][e]; o += __shfl_xor(o, 16); o += __shfl_xor(o, 32); o *= inv[r]; acc[r][e] = o; ss += o * o; }
    ss = wave_sum(jq == 0 ? ss : 0.f);
    if (lane == 0) SSx[wave] = ss;
    __syncthreads();
    const float rstd = 1.f / sqrtf((SSx[ti] + SSx[4 + ti]) * (1.f / 512.f) + 1e-6f);
    if (jq == 0) {
#pragma unroll
        for (int r = 0; r < 4; ++r) { const int ch = (4 * g + r) * 64 + 4 * d4; const f32x4 gn = *(const f32x4*)(a.in[20] + ch);
            u32x2 w; w[0] = cvtpk(acc[r][0] * rstd * gn.x, acc[r][1] * rstd * gn.y); w[1] = cvtpk(acc[r][2] * rstd * gn.z, acc[r][3] * rstd * gn.w);
            *(u32x2*)(MG + (row0 + ti) * 1024 + ch) = w; } }
    __syncthreads();
}
__device__ __forceinline__ void copy_new_kv(const Args& a, int idx) {
    const bf16* QKVU = (const bf16*)(a.ws + WS_QKVU);
    const int c = idx & 31, rr = idx >> 5; size_t row; long dst; bool smp = rr >= 256;
    if (!smp) { const int b = rr >> 7, w = rr & 127; row = (size_t)b * SEQ + (SEQ - 128) + w; dst = (long)(b * 128 + w) * 128; }
    else { const int si = rr - 256; row = (size_t)MP + si; dst = (long)((si >> 2) * 128 + 124 + (si & 3)) * 128; }
    const v4u v = *(const v4u*)(QKVU + row * NPROJ + 512 + 8 * c);
    f32x4 lo, hi; lo.x = __uint_as_float(v.x << 16); lo.y = __uint_as_float(v.x & 0xffff0000u); lo.z = __uint_as_float(v.y << 16); lo.w = __uint_as_float(v.y & 0xffff0000u);
    hi.x = __uint_as_float(v.z << 16); hi.y = __uint_as_float(v.z & 0xffff0000u); hi.z = __uint_as_float(v.w << 16); hi.w = __uint_as_float(v.w & 0xffff0000u);
    float* o = a.out + (c < 16 ? (smp ? O_KS : O_KP) : (smp ? O_VS : O_VP)) + dst + 8 * (c & 15);
    *(f32x4*)o = lo; *(f32x4*)(o + 4) = hi;
}

template <class Epi> __device__ __forceinline__ void mini_tile(LAS unsigned char* L, const bf16* A  , const bf16* Bt  , int K, int tid, const Epi& E, int m0, int n0) {
    const int lane = tid & 63, wave = __builtin_amdgcn_readfirstlane(tid >> 6), c32 = lane & 31, hi = lane >> 5, r8 = lane >> 3, ch = lane & 7;
    LAS unsigned char* SA = L + wave * 12288; LAS unsigned char* SB = SA + 4096;
    const int kw = K >> 3, nblk = kw >> 6;
    const bf16* ga = A + (size_t)r8 * K + wave * kw + ch * 8; const bf16* gb = Bt + (size_t)r8 * K + wave * kw + ch * 8;
    f32x16 acc[2]; acc[0] = f32x16{}; acc[1] = f32x16{};
    v4u ra[4], rb[8];
#pragma unroll
    for (int i = 0; i < 4; ++i) ra[i] = *(const v4u*)(ga + (size_t)(8 * i) * K);
#pragma unroll
    for (int i = 0; i < 8; ++i) rb[i] = *(const v4u*)(gb + (size_t)(8 * i) * K);
#pragma unroll 1
    for (int kb = 0; kb < nblk; ++kb) {
        asm volatile("s_waitcnt lgkmcnt(0)" ::: "memory");
#pragma unroll
        for (int i = 0; i < 4; ++i) { const int n = r8 + 8 * i; *(LAS v4u*)(SA + n * 128 + ((ch ^ ((n >> 1) & 7)) << 4)) = ra[i]; }
#pragma unroll
        for (int i = 0; i < 8; ++i) { const int n = r8 + 8 * i; *(LAS v4u*)(SB + n * 128 + ((ch ^ ((n >> 1) & 7)) << 4)) = rb[i]; }
        if (kb + 1 < nblk) {
#pragma unroll
            for (int i = 0; i < 4; ++i) ra[i] = *(const v4u*)(ga + (size_t)(8 * i) * K + 64 * (kb + 1));
#pragma unroll
            for (int i = 0; i < 8; ++i) rb[i] = *(const v4u*)(gb + (size_t)(8 * i) * K + 64 * (kb + 1)); }
        asm volatile("s_waitcnt lgkmcnt(0)" ::: "memory");
#pragma unroll
        for (int s4 = 0; s4 < 4; ++s4) {
            const bf16x8 af = *(const LAS bf16x8*)(SA + c32 * 128 + (((4 * hi + s4) ^ ((c32 >> 1) & 7)) << 4));
#pragma unroll
            for (int nt = 0; nt < 2; ++nt) { const int n = 32 * nt + c32; const bf16x8 bf = *(const LAS bf16x8*)(SB + n * 128 + (((4 * hi + s4) ^ ((n >> 1) & 7)) << 4));
                acc[nt] = __builtin_amdgcn_mfma_f32_32x32x16_bf16(af, bf, acc[nt], 0, 0, 0); }
        }
    }
    asm volatile("s_waitcnt lgkmcnt(0)" ::: "memory");
    LAS float* P = (LAS float*)SA;
#pragma unroll
    for (int nt = 0; nt < 2; ++nt)
#pragma unroll
        for (int r = 0; r < 16; ++r) P[((r & 3) + 8 * (r >> 2) + 4 * hi) * 64 + 32 * nt + c32] = acc[nt][r];
    __syncthreads();
    { const int m = tid >> 4, n4 = (tid & 15) * 4; f32x4 v = {0.f, 0.f, 0.f, 0.f};
#pragma unroll
      for (int w = 0; w < 8; ++w) v += *(const LAS f32x4*)(L + w * 12288 + (m * 64 + n4) * 4);
      E(m0 + m, n0 + n4, v); }
    __syncthreads();
}
struct MEpiBf16 { bf16* O; int ldc; int act;
    __device__ __forceinline__ void operator()(int m, int n, f32x4 v) const {
        if (act) {
#pragma unroll
            for (int e = 0; e < 4; ++e) { const float x = fmaxf(v[e], 0.f); v[e] = x * x; } }
        u32x2 w; w[0] = cvtpk(v[0], v[1]); w[1] = cvtpk(v[2], v[3]); *(u32x2*)(O + (size_t)m * ldc + n) = w; } };
struct MEpiRes { const float* base; float* O; int ldc; int pad;
    __device__ __forceinline__ void operator()(int m, int n, f32x4 v) const { const f32x4 b = *(const f32x4*)(base + (size_t)m * ldc + n); *(f32x4*)(O + (size_t)m * ldc + n) = b + v; } };
template <class Epi> __device__ __forceinline__ void mini_gemm(LAS unsigned char* L, const bf16* A, const bf16* Bt, int N, int K, const Epi& E, int tile0, int step) {
    const int ntiles = 16 * (N >> 6);
    for (int t = tile0; t < ntiles; t += step) { int tid = threadIdx.x; asm volatile("" : "+v"(tid));
        const int rb = t & 15, cb = t >> 4; mini_tile(L, A + (size_t)(32 * rb) * K, Bt + (size_t)(64 * cb) * K, K, tid, E, 32 * rb, 64 * cb); }
}
__device__ __forceinline__ void phase_prologue(const Args& a, LAS unsigned char* L, int tid, int lane, int wave, int bx, int G) {
    unsigned char* ws = a.ws;
    LAS float* scr = (LAS float*)L + wave * 64 * 33;
    const int gw = bx * 8 + wave, NGW = G * 8;
    constexpr int I_IN = (1024 / 64) * (1280 / 32);
    for (int it = gw; it < I_IN; it += NGW) p0_transpose_item(a.in[8], 1024, 1280, (bf16*)(ws + WS_WIN), scr, it, lane);
    bf16* XN = (bf16*)(ws + WS_XN);
    for (int m = gw; m < M; m += NGW) { const float* xr = m < MP ? a.in[0] + (size_t)m * DM : a.in[1] + (size_t)(m - MP) * DM; rms_row_to_bf16(xr, a.in[7], XN + (size_t)m * DM, lane); }
    const int gt = bx * 512 + tid;
    if (gt < NG * NP) {
        const int g = gt / NP, p = gt % NP;
        const double step = exp((double)a.in[12][g]); const double ar = a.in[10][gt], ai = a.in[11][gt];
        float* LBp = (float*)(ws + SSM_LB);
        const int ex[6] = {1, 16, 32, 48, 64, 512};
        double lr = 0, li = 0;
#pragma unroll
        for (int e = 0; e < 6; ++e) { const double mag = exp(ar * step * ex[e]), r_ = mag * cos(ai * step * ex[e]), i_ = mag * sin(ai * step * ex[e]); if (e == 0) { lr = r_; li = i_; }
            LBp[(e * 2048 + gt) * 2] = (float)r_; LBp[(e * 2048 + gt) * 2 + 1] = (float)i_; }
        const double den = ar * ar + ai * ai; const double cr = ((lr - 1.0) * ar + li * ai) / den, ci = (li * ar - (lr - 1.0) * ai) / den;
        bf16* BBT = (bf16*)(ws + SSM_BBT); bf16* CCT = (bf16*)(ws + SSM_CCT);
        for (int c = 0; c < NC; ++c) { const double br = a.in[13][gt * NC + c], bi = a.in[14][gt * NC + c];
            BBT[((size_t)(g * 2 + 0) * NP + p) * NC + c] = (bf16)f2bf((float)(cr * br - ci * bi)); BBT[((size_t)(g * 2 + 1) * NP + p) * NC + c] = (bf16)f2bf((float)(cr * bi + ci * br));
            CCT[((size_t)(g * NC + c)) * 128 + 2 * p] = (bf16)f2bf(a.in[15][(g * NC + c) * NP + p]); CCT[((size_t)(g * NC + c)) * 128 + 2 * p + 1] = (bf16)f2bf(-a.in[16][(g * NC + c) * NP + p]); }
    }
    { const int nthreads = G * 512; const int total = 128 * 124 * 32;
        for (int i = bx * 512 + tid; i < total; i += nthreads) { const int q = i & 31, sw = i >> 5, s = sw / 124, w = sw % 124;
            const size_t src = ((size_t)(s * 128 + w + 4) * 128) / 4 + q, dst = ((size_t)(s * 128 + w) * 128) / 4 + q;
            ((f32x4*)(a.out + O_KS))[dst] = ((const f32x4*)a.in[2])[src]; ((f32x4*)(a.out + O_VS))[dst] = ((const f32x4*)a.in[3])[src]; } }
}

__device__ __forceinline__ void deferred_transposes(const Args& a, LAS unsigned char* L, int lane, int wave, int gw, int NGW) {
    unsigned char* ws = a.ws; LAS float* scr = (LAS float*)L + wave * 64 * 33;
    constexpr int I_OUT = (1024 / 64) * (1024 / 32), I_UP = (1024 / 64) * (4096 / 32), I_DN = (4096 / 64) * (1024 / 32), I_GLU = (512 / 64) * (512 / 32);
    for (int it = gw; it < I_OUT + I_UP + I_DN + I_GLU; it += NGW) {
        int r = it;
        if (r < I_GLU) { p0_transpose_item(a.in[18], 512, 512, (bf16*)(ws + WS_WGLU), scr, r, lane); continue; } r -= I_GLU;
        if (r < I_OUT) { p0_transpose_item(a.in[22], 1024, 1024, (bf16*)(ws + WS_WOUT), scr, r, lane); continue; } r -= I_OUT;
        if (r < I_UP) { p0_transpose_item(a.in[24], 1024, 4096, (bf16*)(ws + WS_WUP), scr, r, lane); continue; } r -= I_UP;
        p0_transpose_item(a.in[25], 4096, 1024, (bf16*)(ws + WS_WDN), scr, r, lane);
    }
}
__device__ __forceinline__ void phase_rms_final(const Args& a, int lane, int gw, int NGW) {
    for (int row = gw; row < M; row += NGW) {
        f32x4* xr = (f32x4*)(a.out + (size_t)row * DM) + lane; const f32x4* gr = (const f32x4*)a.in[26] + lane;
        f32x4 v[4]; float s = 0.f;
#pragma unroll
        for (int j = 0; j < 4; ++j) { v[j] = xr[64 * j]; s += (v[j].x * v[j].x + v[j].y * v[j].y) + (v[j].z * v[j].z + v[j].w * v[j].w); }
        const float rstd = 1.f / sqrtf(wave_sum(s) * (1.f / 1024.f) + 1e-6f);
#pragma unroll
        for (int j = 0; j < 4; ++j) xr[64 * j] = v[j] * rstd * gr[64 * j];
    }
}

__global__ void __launch_bounds__(512, 2) mk_fwd(Args a) {
    extern __shared__ __attribute__((aligned(16))) unsigned char lds[];
    LAS unsigned char* L = (LAS unsigned char*)lds;
#define FRESH(t) int t = threadIdx.x; asm volatile("" : "+v"(t))
    const int wave = __builtin_amdgcn_readfirstlane(threadIdx.x >> 6);
    const int G = gridDim.x, bx = blockIdx.x, gw = bx * 8 + wave, NGW = G * 8;
    for (int u = threadIdx.x; u < (LDS_BYTES - LDSCTL_OFF) / 4; u += 512) ((LAS unsigned*)(L + LDSCTL_OFF))[u] = 0u;
    __syncthreads();
    unsigned* ctl = (unsigned*)(a.ws + WS_CTL);
    XcdBarrier bar = xcd_barrier_post(ctl + CW_BAR, (volatile LAS unsigned*)(L + MISC_OFF) + 8);
    unsigned char* ws = a.ws;
    bf16 *XN = (bf16*)(ws + WS_XN), *QKVU = (bf16*)(ws + WS_QKVU), *MG = (bf16*)(ws + WS_MERGED), *H = (bf16*)(ws + WS_H);
    PG8_LAS unsigned char* RL = (PG8_LAS unsigned char*)lds;

    { FRESH(t0); phase_prologue(a, L, t0, t0 & 63, wave, bx, G); }
    xcd_barrier(bar);
    { pg8::Gemm g{XN, (const bf16*)(ws + WS_WIN), MP, NPROJ, DM}; pg8::StaticOrder S; S.init(MP, NPROJ, G, bx);
      pg8::gemm_phase<pg8::EpiInProj, pg8::StaticOrder, true, true>(RL, g, S, pg8::EpiInProj{QKVU, a.out, NPROJ, 0});
      const int nu = (MP / 256) * (NPROJ / 256), lo = (G < nu && nu - G < G) ? nu - G : 0;
      if (bx >= lo) { mini_gemm(L, XN + (size_t)MP * DM, (const bf16*)(ws + WS_WIN), NPROJ, DM, MEpiBf16{QKVU + (size_t)MP * NPROJ, NPROJ, 0}, bx - lo, G - lo);
                      FRESH(t2); deferred_transposes(a, L, t2 & 63, wave, (bx - lo) * 8 + wave, (G - lo) * 8); } }
    xcd_barrier(bar);
    { FRESH(t0); attn_build_table(a, L, t0); }
    __syncthreads();
#pragma unroll 1
    for (int rep = 0; rep < REP_ATT; ++rep) for (int u = bx; u < 256; u += G) { FRESH(t2); attn_unit(a, L, t2, t2 & 63, wave, u); }
    { const int half = G >> 1;
      if (bx < half) {
#pragma unroll 1
          for (int rep = 0; rep < REP_SA; ++rep) for (int s = bx; s < 128; s += half) { FRESH(t2); attn_sample_wg(a, L, t2 & 63, wave, s); }
      } else {
#pragma unroll 1
          for (int rep = 0; rep < REP_P1; ++rep) { FRESH(t2); phase_ssm_pass1(a, t2 & 63, wave, bx - half, G - half); }
          { FRESH(t2); for (int idx = (bx - half) * 512 + t2; idx < (256 + 512) * 32; idx += (G - half) * 512) copy_new_kv(a, idx); }
      } }
    xcd_barrier(bar);
#pragma unroll 1
    for (int rep = 0; rep < REP_P3; ++rep) { FRESH(t2); phase_ssm_pass2(a, L, t2, wave, bx, G); }
    xcd_barrier(bar);
    { pg8::Gemm g{MG, (const bf16*)(ws + WS_WOUT), MP, DM, DM}; pg8::StaticOrder S; S.init(MP, DM, G, bx);
      pg8::gemm_phase<pg8::EpiF32Res, pg8::StaticOrder, true, true>(RL, g, S, pg8::EpiF32Res{a.in[0], a.in[1], a.out, DM, 0});
      mini_gemm(L, MG + (size_t)MP * DM, (const bf16*)(ws + WS_WOUT), DM, DM, MEpiRes{a.in[1], a.out + O_YS, DM, 0}, bx, G); }
    xcd_barrier(bar);
    { FRESH(t2); for (int m = gw; m < M; m += NGW) rms_row_to_bf16(a.out + (size_t)m * DM, a.in[23], XN + (size_t)m * DM, t2 & 63); }
    xcd_barrier(bar);
    { pg8::Gemm g{XN, (const bf16*)(ws + WS_WUP), MP, FF, DM}; pg8::StaticOrder S; S.init(MP, FF, G, bx);
      pg8::gemm_phase<pg8::EpiRelu2, pg8::StaticOrder, true, true>(RL, g, S, pg8::EpiRelu2{H, FF, 0});
      mini_gemm(L, XN + (size_t)MP * DM, (const bf16*)(ws + WS_WUP), FF, DM, MEpiBf16{H + (size_t)MP * FF, FF, 1}, bx, G); }
    xcd_barrier(bar);
    { pg8::Gemm g{H, (const bf16*)(ws + WS_WDN), MP, DM, FF}; pg8::StaticOrder S; S.init(MP, DM, G, bx);
      pg8::gemm_phase<pg8::EpiF32Res, pg8::StaticOrder, true, true>(RL, g, S, pg8::EpiF32Res{a.out, a.out + (size_t)MP * DM, a.out, DM, 0});
      mini_gemm(L, H + (size_t)MP * FF, (const bf16*)(ws + WS_WDN), DM, FF, MEpiRes{a.out + O_YS, a.out + O_YS, DM, 0}, bx, G); }
    xcd_barrier(bar);
    { FRESH(t2); phase_rms_final(a, t2 & 63, gw, NGW); }
}

extern "C" void kernel_launch(void* const* d_in, const int* in_sizes, int n_in, void* d_out, int out_size, void* d_ws, size_t ws_size, hipStream_t stream) {
    static int grid = 0;
    if (grid == 0) {
        if (n_in != 27 || out_size != 22093824 || ws_size < WS_END) { fprintf(stderr, "kernel_launch: unexpected sizes n_in %d out %d ws %zu\n", n_in, out_size, ws_size); grid = -1; return; }
        int dev = 0, cus = 0, per_cu = 0;
        if (hipGetDevice(&dev) != hipSuccess || hipDeviceGetAttribute(&cus, hipDeviceAttributeMultiprocessorCount, dev) != hipSuccess) { grid = -1; return; }
        if (hipFuncSetAttribute((const void*)mk_fwd, hipFuncAttributeMaxDynamicSharedMemorySize, LDS_BYTES) != hipSuccess) { fprintf(stderr, "kernel_launch: hipFuncSetAttribute failed\n"); grid = -1; return; }
        if (hipOccupancyMaxActiveBlocksPerMultiprocessor(&per_cu, (const void*)mk_fwd, 512, LDS_BYTES) != hipSuccess || per_cu < 1) fprintf(stderr, "kernel_launch: occupancy query reports %d\n", per_cu);
        (void)hipGetLastError();
        grid = cus;
    }
    if (grid < 0) return;
    if (hipMemsetAsync((char*)d_ws + WS_CTL, 0, CTL_ZERO_BYTES, stream) != hipSuccess) return;
    Args a{};
    for (int i = 0; i < 27; ++i) a.in[i] = (const float*)d_in[i];
    a.out = (float*)d_out; a.ws = (unsigned char*)d_ws;
    hipLaunchKernelGGL(mk_fwd, dim3(grid), dim3(512), LDS_BYTES, stream, a);
}
```
